# Optimizing an MI355X kernel written in HIP

```python
import math
import jax, jax.numpy as jnp
from jax import lax
import numpy as np

D_MODEL = 1024
BATCH = 8
SEQ = 4096
DEPTH = 2

D_MIX = D_MODEL
GROUP_W = D_MIX // 4
POOL_WINDOWS = (2, 4, 8, 16)
POOL_GROUPS = len(POOL_WINDOWS)
POOL_CH = GROUP_W // POOL_GROUPS
SB_HEADS = 4
SB_HEAD_DIM = GROUP_W // SB_HEADS
SB_BLOCK = 128
SGU_HEADS = 4
SGU_HEAD_DIM = GROUP_W // SGU_HEADS
SGU_CHUNK = 128
LRU_BLOCKS = 4
LRU_BLOCK_DIM = GROUP_W // LRU_BLOCKS
CONV_WIDTH = 4
LRU_C = 8.0
D_FF = 2816
OFF_POOL = 0
OFF_Q = OFF_POOL + GROUP_W
OFF_K = OFF_Q + GROUP_W
OFF_V = OFF_K + GROUP_W
OFF_SGU_U = OFF_V + GROUP_W
OFF_SGU_V = OFF_SGU_U + GROUP_W
OFF_LRU_X = OFF_SGU_V + GROUP_W
OFF_LRU_G = OFF_LRU_X + GROUP_W
D_IN = OFF_LRU_G + GROUP_W
EPS = 1e-6

kernel_name = "hybrid_parallel_groups_pool_sb_sgu_rglru_macaron"


def rms_norm(x, g):
    x32 = x.astype(jnp.float32)
    y = x32 * lax.rsqrt(jnp.mean(x32 * x32, axis=-1, keepdims=True) + EPS)
    return (y * g.astype(jnp.float32)).astype(x.dtype)


def swiglu_ffn(x, w_in, w_out):
    gate, up = jnp.split(x @ w_in, 2, axis=-1)
    return (jax.nn.silu(gate) * up) @ w_out


def pool_mixer(xp, w, scale):
    B, S, _ = xp.shape
    x32 = xp.astype(jnp.float32).reshape(B, S, POOL_GROUPS, POOL_CH)
    cs = jnp.cumsum(x32, axis=1)
    counts_base = jnp.arange(1, S + 1, dtype=jnp.int32)
    means = []
    for g, win in enumerate(POOL_WINDOWS):
        csg = cs[:, :, g]
        prev = jnp.pad(csg, ((0, 0), (win, 0), (0, 0)))[:, :S]
        cnt = jnp.minimum(counts_base, win).astype(jnp.float32)[None, :, None]
        means.append((csg - prev) / cnt)
    d = jnp.stack(means, axis=2) - x32
    y = jnp.einsum('bsgc,gcd->bsgd', d, w.astype(jnp.float32)).reshape(B, S, GROUP_W)
    return y * scale.astype(jnp.float32)


def stick_breaking_attention(q, k, v):
    B, S, _ = q.shape
    to_heads = lambda a: a.astype(jnp.float32).reshape(B, S, SB_HEADS, SB_HEAD_DIM).transpose(0, 2, 1, 3)
    q32, k32, v32 = to_heads(q), to_heads(k), to_heads(v)
    scale = 1.0 / math.sqrt(SB_HEAD_DIM)
    key_pos = jnp.arange(S)
    n_blocks = S // SB_BLOCK

    def block(i):
        start = i * SB_BLOCK
        qb = lax.dynamic_slice_in_dim(q32, start, SB_BLOCK, axis=2)
        z = jnp.einsum('bhqd,bhkd->bhqk', qb, k32) * scale
        q_pos = start + jnp.arange(SB_BLOCK)
        mask = key_pos[None, :] < q_pos[:, None]
        log_keep = jnp.where(mask, jax.nn.log_sigmoid(-z), 0.0)
        suffix_incl = jnp.flip(jnp.cumsum(jnp.flip(log_keep, -1), axis=-1), -1)
        suffix_excl = suffix_incl - log_keep
        a = jnp.where(mask, jnp.exp(jax.nn.log_sigmoid(z) + suffix_excl), 0.0)
        return jnp.einsum('bhqk,bhkd->bhqd', a, v32)

    out = lax.map(block, jnp.arange(n_blocks))
    return out.transpose(1, 0, 3, 2, 4).reshape(B, S, GROUP_W)


def spatial_gating(u, v, w_s, b_s):
    B, S, _ = u.shape
    n_chunks = S // SGU_CHUNK
    u32 = jax.nn.gelu(u.astype(jnp.float32))
    v32 = jax.nn.gelu(v.astype(jnp.float32)).reshape(B, n_chunks, SGU_CHUNK, SGU_HEADS, SGU_HEAD_DIM)
    mu = jnp.mean(v32, axis=-1, keepdims=True)
    var = jnp.mean(jnp.square(v32 - mu), axis=-1, keepdims=True)
    vn = (v32 - mu) * lax.rsqrt(var + EPS)
    tri = jnp.tril(jnp.ones((SGU_CHUNK, SGU_CHUNK), jnp.float32))
    ws = w_s.astype(jnp.float32) * tri[None]
    mixed = jnp.einsum('hts,bnshc->bnthc', ws, vn) + b_s.astype(jnp.float32).T[None, None, :, :, None]
    return u32 * mixed.reshape(B, S, GROUP_W)


def rglru_mixer(xb, gb, conv_w, conv_b, wa, ba, wx, bx, lam):
    B, S, C = xb.shape
    xc = lax.conv_general_dilated(
        xb, conv_w[:, None, :], window_strides=(1,), padding=[(CONV_WIDTH - 1, 0)],
        dimension_numbers=('NWC', 'WIO', 'NWC'), feature_group_count=C) + conv_b
    xc32 = xc.astype(jnp.float32)
    xblk = xc32.reshape(B, S, LRU_BLOCKS, LRU_BLOCK_DIM)
    r = jax.nn.sigmoid(jnp.einsum('bsgc,gcd->bsgd', xblk, wa.astype(jnp.float32)).reshape(B, S, C)
                       + ba.astype(jnp.float32))
    i = jax.nn.sigmoid(jnp.einsum('bsgc,gcd->bsgd', xblk, wx.astype(jnp.float32)).reshape(B, S, C)
                       + bx.astype(jnp.float32))
    log_a = -LRU_C * r * jax.nn.softplus(-lam.astype(jnp.float32))
    a = jnp.exp(log_a)
    mult = jnp.sqrt(-jnp.expm1(2.0 * log_a))
    b_in = mult * (i * xc32)

    def combine(e1, e2):
        a1, b1 = e1
        a2, b2 = e2
        return a1 * a2, a2 * b1 + b2

    _, h = lax.associative_scan(combine, (a, b_in), axis=1)
    return h * jax.nn.gelu(gb.astype(jnp.float32))


def setup_inputs(seed: int = 0) -> dict:
    key = jax.random.key(seed)
    ks = iter(jax.random.split(key, 32))
    f32 = jnp.float32

    def nrm(shape, scale):
        return jax.random.normal(next(ks), shape, f32) * scale

    x = jax.random.normal(next(ks), (BATCH, SEQ, D_MODEL), f32)
    ffn1_norm = 1.0 + nrm((DEPTH, D_MODEL), 0.02)
    ffn1_w_in = nrm((DEPTH, D_MODEL, 2 * D_FF), D_MODEL ** -0.5)
    ffn1_w_out = nrm((DEPTH, D_FF, D_MODEL), D_FF ** -0.5)
    mix_norm = 1.0 + nrm((DEPTH, D_MODEL), 0.02)
    mix_w_in = nrm((DEPTH, D_MODEL, D_IN), D_MODEL ** -0.5)
    mix_w_out = nrm((DEPTH, D_MIX, D_MODEL), D_MIX ** -0.5)
    pool_w = nrm((DEPTH, POOL_GROUPS, POOL_CH, POOL_CH), POOL_CH ** -0.5)
    pool_scale = 1.0 + nrm((DEPTH, GROUP_W), 0.1)
    sgu_w = nrm((DEPTH, SGU_HEADS, SGU_CHUNK, SGU_CHUNK), SGU_CHUNK ** -0.5)
    sgu_b = 1.0 + nrm((DEPTH, SGU_HEADS, SGU_CHUNK), 0.02)
    conv_w = nrm((DEPTH, CONV_WIDTH, GROUP_W), CONV_WIDTH ** -0.5)
    conv_b = nrm((DEPTH, GROUP_W), 0.01)
    lru_wa = nrm((DEPTH, LRU_BLOCKS, LRU_BLOCK_DIM, LRU_BLOCK_DIM), LRU_BLOCK_DIM ** -0.5)
    lru_ba = nrm((DEPTH, GROUP_W), 0.01)
    lru_wx = nrm((DEPTH, LRU_BLOCKS, LRU_BLOCK_DIM, LRU_BLOCK_DIM), LRU_BLOCK_DIM ** -0.5)
    lru_bx = nrm((DEPTH, GROUP_W), 0.01)
    a_c = jax.random.uniform(next(ks), (DEPTH, GROUP_W), f32, 0.9, 0.999)
    s = a_c ** (1.0 / LRU_C)
    lru_lambda = jnp.log(s) - jnp.log1p(-s)
    ffn2_norm = 1.0 + nrm((DEPTH, D_MODEL), 0.02)
    ffn2_w_in = nrm((DEPTH, D_MODEL, 2 * D_FF), D_MODEL ** -0.5)
    ffn2_w_out = nrm((DEPTH, D_FF, D_MODEL), D_FF ** -0.5)
    final_norm = 1.0 + nrm((D_MODEL,), 0.02)
    return {
        "x": x, "ffn1_norm": ffn1_norm, "ffn1_w_in": ffn1_w_in, "ffn1_w_out": ffn1_w_out,
        "mix_norm": mix_norm, "mix_w_in": mix_w_in, "mix_w_out": mix_w_out,
        "pool_w": pool_w, "pool_scale": pool_scale, "sgu_w": sgu_w, "sgu_b": sgu_b,
        "conv_w": conv_w, "conv_b": conv_b, "lru_wa": lru_wa, "lru_ba": lru_ba,
        "lru_wx": lru_wx, "lru_bx": lru_bx, "lru_lambda": lru_lambda,
        "ffn2_norm": ffn2_norm, "ffn2_w_in": ffn2_w_in, "ffn2_w_out": ffn2_w_out,
        "final_norm": final_norm,
    }


def reference(x, ffn1_norm, ffn1_w_in, ffn1_w_out, mix_norm, mix_w_in, mix_w_out,
              pool_w, pool_scale, sgu_w, sgu_b, conv_w, conv_b, lru_wa, lru_ba,
              lru_wx, lru_bx, lru_lambda, ffn2_norm, ffn2_w_in, ffn2_w_out, final_norm):
    for l in range(DEPTH):
        x = x + 0.5 * swiglu_ffn(rms_norm(x, ffn1_norm[l]), ffn1_w_in[l], ffn1_w_out[l])
        h = rms_norm(x, mix_norm[l])
        p = h @ mix_w_in[l]
        y_pool = pool_mixer(p[..., OFF_POOL:OFF_Q], pool_w[l], pool_scale[l])
        y_sb = stick_breaking_attention(p[..., OFF_Q:OFF_K], p[..., OFF_K:OFF_V], p[..., OFF_V:OFF_SGU_U])
        y_sgu = spatial_gating(p[..., OFF_SGU_U:OFF_SGU_V], p[..., OFF_SGU_V:OFF_LRU_X], sgu_w[l], sgu_b[l])
        y_lru = rglru_mixer(p[..., OFF_LRU_X:OFF_LRU_G], p[..., OFF_LRU_G:D_IN], conv_w[l], conv_b[l],
                            lru_wa[l], lru_ba[l], lru_wx[l], lru_bx[l], lru_lambda[l])
        y = jnp.concatenate([y_pool, y_sb, y_sgu, y_lru], axis=-1).astype(x.dtype)
        x = x + y @ mix_w_out[l]
        x = x + 0.5 * swiglu_ffn(rms_norm(x, ffn2_norm[l]), ffn2_w_in[l], ffn2_w_out[l])
    return rms_norm(x, final_norm)
```

```cpp
#include <hip/hip_runtime.h>
#include <hip/hip_cooperative_groups.h>
#include <cstdio>
#include <cstdint>
namespace cg = cooperative_groups;
namespace pg8 {
#define PG8_LAS __attribute__((address_space(3)))
typedef unsigned short bf16_t;
typedef short bf16x8 __attribute__((ext_vector_type(8)));
typedef float f32x4 __attribute__((ext_vector_type(4)));
typedef unsigned u32x4 __attribute__((ext_vector_type(4)));
constexpr int BM = 256, BK = 64, HALF = 128, HTB = HALF * BK * 2  , STAGE_BYTES = 8 * HTB, NXCD = 8, WGM = 8;

__host__ __device__ __forceinline__ int lds_byte(int r, int c) { const int st = (r >> 4) * 2 + (c >> 5), rr = r & 15, cc = c & 31, ob = rr * 64 + cc * 2; return st * 1024 + (ob ^ (((ob >> 9) & 1) << 5)); }
__host__ __device__ __forceinline__ void stage_rc(int b, int& R, int& C) { const int st = b / 1024, sb = b % 1024, swz = sb ^ (((sb >> 9) & 1) << 5); R = (st >> 1) * 16 + swz / 64; C = (st & 1) * 32 + (swz % 64) / 2; }
__host__ __device__ __forceinline__ int perm32(int rho) { const int n = rho >> 4, i = rho & 15; return 8 * (i >> 2) + 4 * n + (i & 3); }

struct Unit { int pm, pn; };
struct Gemm { const bf16_t* A; const bf16_t* Bt; int M, N, K; };

struct StaticOrder {
    int nM, nN, nwg, G, c;
    __host__ __device__ void init(int M, int N, int G_, int c_) { nM = M / BM; nN = N / BM; nwg = nM * nN; G = G_; c = c_; }
    __host__ __device__ bool next(int i, Unit& u) const {
        const long L = (long)i * G + c; if (L >= nwg) return false;
        int wgid = (int)L; { const int q = nwg / NXCD, r = nwg % NXCD, xcd = wgid % NXCD, off = wgid / NXCD; wgid = (xcd < r ? xcd * (q + 1) : r * (q + 1) + (xcd - r) * q) + off; }
        const int nig = WGM * nN, gid = wgid / nig, fm = gid * WGM, gsz = (nM - fm) < WGM ? (nM - fm) : WGM;
        u.pm = fm + ((wgid % nig) % gsz); u.pn = (wgid % nig) / gsz; return true;
    }
    __device__ __forceinline__ void a_ready(const Unit&) const {}
    __device__ __forceinline__ void done(const Unit&) const {}
};

__device__ __forceinline__ unsigned cvt_pk_bf16(float lo, float hi) { unsigned r; asm volatile("v_cvt_pk_bf16_f32 %0, %1, %2" : "=v"(r) : "v"(lo), "v"(hi)); return r; }
template <class Epi, class Sched, bool ALIGN_EPI = false, bool SP2 = false>
__device__ __forceinline__ void gemm_phase(PG8_LAS unsigned char* lds, const Gemm g, const Sched& S, const Epi& E) {
    int tid_ = threadIdx.x; asm volatile("" : "+v"(tid_));
    const int tid = tid_, wid = __builtin_amdgcn_readfirstlane(tid >> 6), lane = tid & 63, wr = wid >> 2, wc = wid & 3, fr = lane & 15, fq = lane >> 4;
    const int K = g.K, nt = K / BK;
    unsigned voffA[2], voffB[2];
#pragma unroll
    for (int i = 0; i < 2; ++i) { int R, C; stage_rc(tid * 16 + i * 8192, R, C); const int Rb = Epi::PERM ? ((R & ~31) + perm32(R & 31)) : R;
        voffA[i] = (unsigned)(R * K + C) * 2u; voffB[i] = (unsigned)(Rb * K + C) * 2u; }
    const size_t kstep = (size_t)(BK * 2);
    const size_t hstep = (size_t)HALF * K * 2;
    const size_t tstep = 2 * hstep;
    const unsigned ldsw = (unsigned)wid * 1024u;
    const int aoff = lds_byte(wr * 64 + fr, fq * 8), boff = lds_byte(wc * 32 + fr, fq * 8);
#define PG8_SA(b, h) (((b) * 2 + (h)) * HTB)
#define PG8_SB(b, h) ((4 + (b) * 2 + (h)) * HTB)
#define PG8_STAGE(bufoff, gbase, voff) do { _Pragma("unroll") for (int _i = 0; _i < 2; ++_i) \
        __builtin_amdgcn_global_load_lds((const unsigned*)((const char*)(gbase) + (voff)[_i]), (PG8_LAS unsigned*)(lds + (bufoff) + ldsw + _i * 8192), 16, 0, 0); } while (0)
#define PG8_LDA(dst, b, h) do { _Pragma("unroll") for (int m = 0; m < 4; ++m) _Pragma("unroll") for (int k = 0; k < 2; ++k) dst[m][k] = *(const PG8_LAS bf16x8*)(lds + PG8_SA(b, h) + aoff + m * 2048 + k * 1024); } while (0)
#define PG8_LDB(dst, b, h) do { _Pragma("unroll") for (int n = 0; n < 2; ++n) _Pragma("unroll") for (int k = 0; k < 2; ++k) dst[n][k] = *(const PG8_LAS bf16x8*)(lds + PG8_SB(b, h) + boff + n * 2048 + k * 1024); } while (0)
#define PG8_MMA(ai, bj, At, Bt) do { __builtin_amdgcn_s_setprio(1); _Pragma("unroll") for (int m = 0; m < 4; ++m) _Pragma("unroll") for (int n = 0; n < 2; ++n) _Pragma("unroll") for (int k = 0; k < 2; ++k) \
        acc[ai][bj][m][n] = __builtin_amdgcn_mfma_f32_16x16x32_bf16(Bt[n][k], At[m][k], acc[ai][bj][m][n], 0, 0, 0); __builtin_amdgcn_s_setprio(0); } while (0)
#define PG8_WAIT_V(n) asm volatile("s_waitcnt vmcnt(" #n ")" ::: "memory")
#define PG8_WAIT_L(n) asm volatile("s_waitcnt lgkmcnt(" #n ")" ::: "memory")
#define PG8_BAR __builtin_amdgcn_s_barrier()
#define PG8_SCHED __builtin_amdgcn_sched_barrier(0)
    Unit cur, nxt; int ui = 0;
    if (!S.next(0, cur)) return;
    f32x4 acc[2][2][4][2];
#pragma unroll
    for (int a = 0; a < 2; ++a)
#pragma unroll
        for (int b = 0; b < 2; ++b)
#pragma unroll
            for (int m = 0; m < 4; ++m)
#pragma unroll
                for (int n = 0; n < 2; ++n) acc[a][b][m][n] = (f32x4){0.f, 0.f, 0.f, 0.f};
    bf16x8 At[4][2], B0[2][2], B1[2][2];
    const char* cA = (const char*)g.A + (size_t)cur.pm * tstep; const char* cB = (const char*)g.Bt + (size_t)cur.pn * tstep;
    S.a_ready(cur);
    if constexpr (SP2) {
        PG8_STAGE(PG8_SB(0, 0), cB, voffB); PG8_STAGE(PG8_SB(0, 1), cB + hstep, voffB); PG8_STAGE(PG8_SA(0, 0), cA, voffA); PG8_STAGE(PG8_SA(0, 1), cA + hstep, voffA);
        if (wr == 1) PG8_BAR;
        PG8_WAIT_V(2); PG8_BAR;
        PG8_STAGE(PG8_SB(1, 0), cB + kstep, voffB); PG8_STAGE(PG8_SA(1, 0), cA + kstep, voffA); PG8_STAGE(PG8_SB(1, 1), cB + hstep + kstep, voffB);
        PG8_WAIT_V(6); PG8_BAR;
    } else {
        PG8_STAGE(PG8_SB(0, 0), cB, voffB); PG8_STAGE(PG8_SA(0, 0), cA, voffA); PG8_STAGE(PG8_SB(0, 1), cB + hstep, voffB); PG8_STAGE(PG8_SA(0, 1), cA + hstep, voffA);
        if (wr == 1) PG8_BAR;
        PG8_WAIT_V(4); PG8_BAR;
        PG8_STAGE(PG8_SB(1, 0), cB + kstep, voffB); PG8_STAGE(PG8_SA(1, 0), cA + kstep, voffA); PG8_STAGE(PG8_SB(1, 1), cB + hstep + kstep, voffB);
        PG8_WAIT_V(6); PG8_BAR;
    }
    for (;;) {
        const bool has_next = S.next(ui + 1, nxt);
        const char* nA = has_next ? (const char*)g.A + (size_t)nxt.pm * tstep : cA; const char* nB = has_next ? (const char*)g.Bt + (size_t)nxt.pn * tstep : cB;
        for (int t = 0; t < nt; t += 2) {
            const bool last = (t == nt - 2);
            const char* a1 = cA + (size_t)(t + 1) * kstep;
            const char* a2 = last ? nA : cA + (size_t)(t + 2) * kstep; const char* b2 = last ? nB : cB + (size_t)(t + 2) * kstep;
            const char* a3 = a2 + kstep; const char* b3 = b2 + kstep;
            if (last && has_next) S.a_ready(nxt);
            if constexpr (SP2) {
            PG8_LDB(B0, 0, 0); PG8_LDB(B1, 0, 1); PG8_SCHED; PG8_LDA(At, 0, 0); PG8_STAGE(PG8_SA(1, 1), a1 + hstep, voffA);
            PG8_WAIT_V(8); PG8_WAIT_L(0); PG8_BAR; PG8_MMA(0, 0, At, B0); PG8_MMA(0, 1, At, B1); PG8_BAR; PG8_SCHED;
            PG8_LDA(At, 0, 1); PG8_STAGE(PG8_SB(0, 0), b2, voffB); PG8_STAGE(PG8_SB(0, 1), b2 + hstep, voffB); PG8_STAGE(PG8_SA(0, 0), a2, voffA);
            PG8_WAIT_V(8); PG8_WAIT_L(0); PG8_BAR; PG8_MMA(1, 0, At, B0); PG8_MMA(1, 1, At, B1); PG8_BAR; PG8_SCHED;
            PG8_LDB(B0, 1, 0); PG8_LDB(B1, 1, 1); PG8_SCHED; PG8_LDA(At, 1, 0); PG8_STAGE(PG8_SA(0, 1), a2 + hstep, voffA);
            PG8_WAIT_V(8); PG8_WAIT_L(0); PG8_BAR; PG8_MMA(0, 0, At, B0); PG8_MMA(0, 1, At, B1); PG8_BAR; PG8_SCHED;
            PG8_LDA(At, 1, 1); PG8_STAGE(PG8_SB(1, 0), b3, voffB); PG8_STAGE(PG8_SB(1, 1), b3 + hstep, voffB); PG8_STAGE(PG8_SA(1, 0), a3, voffA);
            PG8_WAIT_V(8); PG8_WAIT_L(0); PG8_BAR; PG8_MMA(1, 0, At, B0); PG8_MMA(1, 1, At, B1); PG8_BAR; PG8_SCHED;
            } else {
            PG8_LDB(B0, 0, 0); PG8_SCHED; PG8_LDA(At, 0, 0); PG8_STAGE(PG8_SA(1, 1), a1 + hstep, voffA);
            PG8_WAIT_L(8); PG8_BAR; PG8_WAIT_L(0); PG8_MMA(0, 0, At, B0); PG8_BAR; PG8_SCHED;
            PG8_LDB(B1, 0, 1); PG8_STAGE(PG8_SB(0, 0), b2, voffB);
            PG8_BAR; PG8_WAIT_L(0); PG8_MMA(0, 1, At, B1); PG8_BAR;
            PG8_LDA(At, 0, 1); PG8_STAGE(PG8_SA(0, 0), a2, voffA);
            PG8_BAR; PG8_WAIT_L(0); PG8_MMA(1, 0, At, B0); PG8_BAR; PG8_SCHED;
            PG8_STAGE(PG8_SB(0, 1), b2 + hstep, voffB);
            PG8_WAIT_V(6); PG8_BAR; PG8_MMA(1, 1, At, B1); PG8_BAR;
            PG8_LDB(B0, 1, 0); PG8_SCHED; PG8_LDA(At, 1, 0); PG8_STAGE(PG8_SA(0, 1), a2 + hstep, voffA);
            PG8_WAIT_L(8); PG8_BAR; PG8_WAIT_L(0); PG8_MMA(0, 0, At, B0); PG8_BAR; PG8_SCHED;
            PG8_LDB(B1, 1, 1); PG8_STAGE(PG8_SB(1, 0), b3, voffB);
            PG8_BAR; PG8_WAIT_L(0); PG8_MMA(0, 1, At, B1); PG8_BAR;
            PG8_LDA(At, 1, 1); PG8_STAGE(PG8_SA(1, 0), a3, voffA);
            PG8_BAR; PG8_WAIT_L(0); PG8_MMA(1, 0, At, B0); PG8_BAR; PG8_SCHED;
            PG8_STAGE(PG8_SB(1, 1), b3 + hstep, voffB);
            PG8_WAIT_V(6); PG8_BAR; PG8_MMA(1, 1, At, B1); PG8_BAR;
            }
        }
        if constexpr (ALIGN_EPI) { if (wr == 0) PG8_BAR; }
        if constexpr (!Epi::AFTER_DRAIN) { E(acc, cur, wr, wc, fr, fq); S.done(cur); }
        if (!has_next) break;
#pragma unroll
        for (int a = 0; a < 2; ++a)
#pragma unroll
            for (int b = 0; b < 2; ++b)
#pragma unroll
                for (int m = 0; m < 4; ++m)
#pragma unroll
                    for (int n = 0; n < 2; ++n) acc[a][b][m][n] = (f32x4){0.f, 0.f, 0.f, 0.f};
        cur = nxt; cA = nA; cB = nB; ++ui;
        if constexpr (ALIGN_EPI) { if (wr == 1) PG8_BAR; }
    }
    PG8_WAIT_V(0);
    if constexpr (!ALIGN_EPI) { if (wr == 0) PG8_BAR; }
    PG8_BAR;
    if constexpr (Epi::AFTER_DRAIN) { E.fused(acc, cur, wr, wc, fr, fq, lds, wid, lane); S.done(cur); }
#undef PG8_SA
#undef PG8_SB
#undef PG8_STAGE
#undef PG8_LDA
#undef PG8_LDB
#undef PG8_MMA
#undef PG8_WAIT_V
#undef PG8_WAIT_L
#undef PG8_BAR
#undef PG8_SCHED
}
}
namespace pg8 {
constexpr float RMS_EPS = 1e-6f;
typedef unsigned long long ssq_t;
constexpr float SSQ_SCALE = 1048576.0f, SSQ_INV = 1.0f / 1048576.0f;
__device__ __forceinline__ ssq_t ssq_from_float(float s) { return (ssq_t)__float2ull_rn(s * SSQ_SCALE); }
__device__ __forceinline__ float ssq_to_float(ssq_t v) { return (float)v * SSQ_INV; }
typedef float f32x2 __attribute__((ext_vector_type(2)));
__device__ __forceinline__ float fast_sigmoid(float x) { return __builtin_amdgcn_rcpf(1.0f + __builtin_amdgcn_exp2f(-1.4426950408889634f * x)); }
struct EpiSwiGLU {
    static constexpr bool PERM = true, AFTER_DRAIN = false;
    bf16_t* O; const ssq_t* ss; int ldo;
    __device__ __forceinline__ void operator()(const f32x4 (&acc)[2][2][4][2], const Unit& u, int wr, int wc, int fr, int fq) const {
        const int row0 = u.pm * BM + wr * 64 + fr, col0 = u.pn * 128 + wc * 32 + 8 * fq;
        float rsv[2][4];
#pragma unroll
        for (int ai = 0; ai < 2; ++ai)
#pragma unroll
            for (int m = 0; m < 4; ++m) rsv[ai][m] = ssq_to_float(ss[row0 + ai * HALF + m * 16]);
#pragma unroll
        for (int ai = 0; ai < 2; ++ai)
#pragma unroll
            for (int m = 0; m < 4; ++m) {
                const int row = row0 + ai * HALF + m * 16;
                const float rs = __builtin_amdgcn_rsqf(rsv[ai][m] * (1.0f / 1024.0f) + RMS_EPS);
                const float rsn = rs * -1.4426950408889634f, rsq = rs * rs;
                float o[8];
#pragma unroll
                for (int n = 0; n < 2; ++n)
#pragma unroll
                    for (int i = 0; i < 4; i += 2) { const f32x2 g2 = (f32x2){acc[ai][0][m][n][i], acc[ai][0][m][n][i + 1]}, u2 = (f32x2){acc[ai][1][m][n][i], acc[ai][1][m][n][i + 1]};
                        const f32x2 t2 = g2 * rsn; f32x2 e2; e2.x = __builtin_amdgcn_exp2f(t2.x); e2.y = __builtin_amdgcn_exp2f(t2.y);
                        const f32x2 d2 = e2 + 1.0f; f32x2 r2; r2.x = __builtin_amdgcn_rcpf(d2.x); r2.y = __builtin_amdgcn_rcpf(d2.y);
                        const f32x2 o2 = ((g2 * u2) * rsq) * r2; o[4 * n + i] = o2.x; o[4 * n + i + 1] = o2.y; }
                u32x4 w; w.x = cvt_pk_bf16(o[0], o[1]); w.y = cvt_pk_bf16(o[2], o[3]); w.z = cvt_pk_bf16(o[4], o[5]); w.w = cvt_pk_bf16(o[6], o[7]);
                *(u32x4*)(O + (size_t)row * ldo + col0) = w;
            }
    }
};
struct EpiMixIn {
    static constexpr bool PERM = true, AFTER_DRAIN = false;
    bf16_t* O; const ssq_t* ss; bf16_t* Vt;
    __device__ __forceinline__ void operator()(const f32x4 (&acc)[2][2][4][2], const Unit& u, int wr, int wc, int fr, int fq) const {
        const int row0 = u.pm * BM + wr * 64 + fr;
        float rsv[2][4];
#pragma unroll
        for (int ai = 0; ai < 2; ++ai)
#pragma unroll
            for (int m = 0; m < 4; ++m) rsv[ai][m] = ssq_to_float(ss[row0 + ai * HALF + m * 16]);
#pragma unroll
        for (int ai = 0; ai < 2; ++ai)
#pragma unroll
            for (int m = 0; m < 4; ++m) {
                const int row = row0 + ai * HALF + m * 16;
                const float rs = __builtin_amdgcn_rsqf(rsv[ai][m] * (1.0f / 1024.0f) + RMS_EPS);
#pragma unroll
                for (int bj = 0; bj < 2; ++bj) {
                    const f32x4 v0 = acc[ai][bj][m][0] * rs, v1 = acc[ai][bj][m][1] * rs;
                    if (u.pn != 3) {
                        u32x4 w; w.x = cvt_pk_bf16(v0[0], v0[1]); w.y = cvt_pk_bf16(v0[2], v0[3]); w.z = cvt_pk_bf16(v1[0], v1[1]); w.w = cvt_pk_bf16(v1[2], v1[3]);
                        *(u32x4*)(O + (size_t)row * 2048 + u.pn * BM + bj * HALF + wc * 32 + 8 * fq) = w;
                    } else {
                        const int b = row >> 12, s = row & 4095, cl = bj * HALF + wc * 32 + 8 * fq;
                        bf16_t* vp = Vt + ((size_t)(b * 256 + cl) * 4096 + s);
                        const unsigned w0 = cvt_pk_bf16(v0[0], v0[1]), w1 = cvt_pk_bf16(v0[2], v0[3]), w2 = cvt_pk_bf16(v1[0], v1[1]), w3 = cvt_pk_bf16(v1[2], v1[3]);
                        const unsigned x0 = __shfl_xor(w0, 1), x1 = __shfl_xor(w1, 1), x2 = __shfl_xor(w2, 1), x3 = __shfl_xor(w3, 1);
                        const bool odd = fr & 1; bf16_t* vq = vp - (odd ? 1 : 0) + (odd ? 4096 : 0);
                        const unsigned p0 = odd ? ((x0 >> 16) | (w0 & 0xffff0000u)) : ((w0 & 0xffffu) | (x0 << 16));
                        const unsigned p1 = odd ? ((x1 >> 16) | (w1 & 0xffff0000u)) : ((w1 & 0xffffu) | (x1 << 16));
                        const unsigned p2 = odd ? ((x2 >> 16) | (w2 & 0xffff0000u)) : ((w2 & 0xffffu) | (x2 << 16));
                        const unsigned p3 = odd ? ((x3 >> 16) | (w3 & 0xffff0000u)) : ((w3 & 0xffffu) | (x3 << 16));
                        *(unsigned*)(vq + 0 * 4096) = p0; *(unsigned*)(vq + 2 * 4096) = p1; *(unsigned*)(vq + 4 * 4096) = p2; *(unsigned*)(vq + 6 * 4096) = p3;
                    }
                }
            }
    }
};
struct EpiResidual {
    static constexpr bool PERM = true, AFTER_DRAIN = false;
    const float* Xin32; bf16_t* XB; ssq_t* ssn; float alpha;
    __device__ __forceinline__ void operator()(const f32x4 (&acc)[2][2][4][2], const Unit& u, int wr, int wc, int fr, int fq) const {
        const int row0 = u.pm * BM + wr * 64 + fr, col0 = u.pn * BM + wc * 32 + 8 * fq;
        u32x4 xw[2][4][2];
#pragma unroll
        for (int ai = 0; ai < 2; ++ai)
#pragma unroll
            for (int m = 0; m < 4; ++m)
#pragma unroll
                for (int bj = 0; bj < 2; ++bj) xw[ai][m][bj] = *(const u32x4*)(XB + (size_t)(row0 + ai * HALF + m * 16) * 1024 + col0 + bj * HALF);
#pragma unroll
        for (int ai = 0; ai < 2; ++ai) {
#pragma unroll
            for (int m = 0; m < 4; ++m) {
                const int row = row0 + ai * HALF + m * 16; float s = 0.f;
#pragma unroll
                for (int bj = 0; bj < 2; ++bj) {
                    const size_t off = (size_t)row * 1024 + col0 + bj * HALF;
                    const u32x4 w0 = xw[ai][m][bj];
                    const f32x4 x0 = (f32x4){__uint_as_float(w0.x << 16), __uint_as_float(w0.x & 0xffff0000u), __uint_as_float(w0.y << 16), __uint_as_float(w0.y & 0xffff0000u)};
                    const f32x4 x1 = (f32x4){__uint_as_float(w0.z << 16), __uint_as_float(w0.z & 0xffff0000u), __uint_as_float(w0.w << 16), __uint_as_float(w0.w & 0xffff0000u)};
                    const f32x4 v0 = x0 + acc[ai][bj][m][0] * alpha, v1 = x1 + acc[ai][bj][m][1] * alpha;
                    u32x4 w; w.x = cvt_pk_bf16(v0[0], v0[1]); w.y = cvt_pk_bf16(v0[2], v0[3]); w.z = cvt_pk_bf16(v1[0], v1[1]); w.w = cvt_pk_bf16(v1[2], v1[3]);
                    *(u32x4*)(XB + off) = w;
                    s += (v0[0] * v0[0] + v0[1] * v0[1]) + (v0[2] * v0[2] + v0[3] * v0[3]) + (v1[0] * v1[0] + v1[1] * v1[1]) + (v1[2] * v1[2] + v1[3] * v1[3]);
                }
                s += __shfl_xor(s, 16); s += __shfl_xor(s, 32);
                if (fq == 0) atomicAdd(ssn + row, ssq_from_float(s));
            }
        }
    }
};
struct EpiNone { static constexpr bool PERM = true, AFTER_DRAIN = false; float* sink;
    __device__ __forceinline__ void operator()(const f32x4 (&acc)[2][2][4][2], const Unit& u, int wr, int wc, int fr, int fq) const { f32x4 t = (f32x4){0.f, 0.f, 0.f, 0.f};
#pragma unroll
        for (int a = 0; a < 2; ++a)
#pragma unroll
            for (int b = 0; b < 2; ++b)
#pragma unroll
                for (int m = 0; m < 4; ++m)
#pragma unroll
                    for (int n = 0; n < 2; ++n) t += acc[a][b][m][n];
        if (t[0] + t[1] + t[2] + t[3] == 1.2345e-30f) sink[0] = t[0]; } };
}

#define LAS __attribute__((address_space(3)))
typedef unsigned short bf16;
typedef float f32x4 __attribute__((ext_vector_type(4)));
typedef short bf16x8 __attribute__((ext_vector_type(8)));
typedef unsigned u32x4 __attribute__((ext_vector_type(4)));
typedef unsigned u32x2 __attribute__((ext_vector_type(2)));
constexpr int NWAVES = 8, NT = 512;
constexpr int BATCH = 8, SEQ = 4096, D = 1024, M = BATCH * SEQ, DFF = 2816, DIN = 2048, DEPTH = 2;
constexpr size_t MiB = 1u << 20;
constexpr size_t WS_CTL = 0, WS_SS = 1 * MiB, WS_SMALL = 3 * MiB, WS_W = 4 * MiB, W_LAYER = 39 * MiB;
constexpr size_t WO_F1IN = 0, WO_F1OUT = 11 * MiB, WO_MIN = 16 * MiB + MiB / 2, WO_MOUT = 20 * MiB + MiB / 2, WO_F2IN = 22 * MiB + MiB / 2, WO_F2OUT = 33 * MiB + MiB / 2;
constexpr size_t WS_XB = 84 * MiB, WS_Y = 148 * MiB, WS_VT = 212 * MiB, WS_ACT = 228 * MiB, WS_EF = 404 * MiB, WS_SUM = 468 * MiB, WS_END = 469 * MiB;
constexpr size_t SM_POOL = 0, SM_LRUA = 64 * 1024, SM_LRUX = 128 * 1024, SM_SGU = 192 * 1024, SM_SPL = 512 * 1024;
constexpr int ZERO_BYTES = 3 * (1 << 20);
constexpr int LDS_BYTES = 147456, RING_BYTES = 131072;
#ifndef REP_PRO
#define REP_PRO 1
#endif
#ifndef REP_P0
#define REP_P0 1
#endif
#ifndef REP_P1
#define REP_P1 1
#endif
#ifndef REP_FIN
#define REP_FIN 1
#endif
constexpr int CW_BAR = 4096;
constexpr int CW_QUEUE = 1024;
constexpr int CW_FLG = 8192;

__device__ __forceinline__ float bf2f(unsigned b) { return __uint_as_float(b << 16); }
__device__ __forceinline__ unsigned f2bf(float f) { unsigned u = __float_as_uint(f); return (u + 0x7fffu + ((u >> 16) & 1u)) >> 16; }
__device__ __forceinline__ unsigned pk2(float lo, float hi) { return pg8::cvt_pk_bf16(lo, hi); }
__device__ __forceinline__ float sigmoidf_(float x) { return __builtin_amdgcn_rcpf(1.0f + __builtin_amdgcn_exp2f(-1.4426950408889634f * x)); }
__device__ __forceinline__ float gelu_tanh(float x) { const float u2 = 1.5957691216057308f * (x + 0.044715f * x * x * x); return x * sigmoidf_(u2); }
__device__ __forceinline__ float wave_sum(float v) {
#pragma unroll
    for (int o = 1; o < 64; o <<= 1) v += __shfl_xor(v, o);
    return v;
}

struct Args { const float* in[22]; float* out; unsigned char* ws; int ph_lo, ph_hi; };
enum { I_X = 0, I_F1N, I_F1WI, I_F1WO, I_MN, I_MWI, I_MWO, I_PW, I_PS, I_SW, I_SB, I_CW, I_CB, I_LWA, I_LBA, I_LWX, I_LBX, I_LAM, I_F2N, I_F2WI, I_F2WO, I_FN };

__device__ __forceinline__ void transpose_item(const float* W, int K, int N, bf16* WT, const float* gk, int mode, LAS float* scr, int item, int lane) {
    const int nblk = N / 32, kb = item / nblk, nb = item % nblk, k0 = 64 * kb, n0 = 32 * nb;
    { f32x4 v[8]; float gsc[8];
#pragma unroll
      for (int i = 0; i < 8; ++i) { const int kk = 8 * i + (lane >> 3); v[i] = *(const f32x4*)(W + (size_t)(k0 + kk) * N + n0 + 4 * (lane & 7)); gsc[i] = gk ? gk[k0 + kk] : 1.0f; }
#pragma unroll
      for (int i = 0; i < 8; ++i) { const int kk = 8 * i + (lane >> 3); LAS float* d = scr + kk * 33 + 4 * (lane & 7); d[0] = v[i][0] * gsc[i]; d[1] = v[i][1] * gsc[i]; d[2] = v[i][2] * gsc[i]; d[3] = v[i][3] * gsc[i]; } }
    asm volatile("s_waitcnt lgkmcnt(0)" ::: "memory");
    int r0 = n0;
    if (mode == 1) r0 = (n0 < DFF) ? (256 * (n0 / 128) + n0 % 128) : (256 * ((n0 - DFF) / 128) + 128 + (n0 - DFF) % 128);
    const int c = lane & 7;
#pragma unroll
    for (int j = 0; j < 4; ++j) { const int n = (lane >> 3) + 8 * j; const LAS float* s = scr + (8 * c) * 33 + n;
        u32x4 o; o.x = pk2(s[0 * 33], s[1 * 33]); o.y = pk2(s[2 * 33], s[3 * 33]); o.z = pk2(s[4 * 33], s[5 * 33]); o.w = pk2(s[6 * 33], s[7 * 33]);
        *(u32x4*)(WT + (size_t)(r0 + n) * K + k0 + 8 * c) = o; }
    asm volatile("s_waitcnt lgkmcnt(0)" ::: "memory");
}

__device__ __forceinline__ void prologue(const Args& a, LAS unsigned char* lds, int G, int bid, int wave, int lane, int tid) {
    asm volatile("" : "+v"(tid)); lane = tid & 63;
    unsigned char* ws = a.ws;
    LAS float* scr = (LAS float*)(lds + wave * 16384);
    const int gw = bid * NWAVES + wave, NGW = G * NWAVES;
    constexpr int IT_FIN = (D / 64) * (2 * DFF / 32), IT_FOUT = (DFF / 64) * (D / 32), IT_MIN = (D / 64) * (DIN / 32), IT_MOUT = (D / 64) * (D / 32);
    constexpr int IT_LAYER = 2 * IT_FIN + 2 * IT_FOUT + IT_MIN + IT_MOUT;
    for (int it = gw; it < DEPTH * IT_LAYER; it += NGW) {
        const int l = it / IT_LAYER; int r = it % IT_LAYER; unsigned char* wl = ws + WS_W + l * W_LAYER;
        if (r < IT_FIN) { transpose_item(a.in[I_F1WI] + (size_t)l * D * 2 * DFF, D, 2 * DFF, (bf16*)(wl + WO_F1IN), a.in[I_F1N] + l * D, 1, scr, r, lane); continue; } r -= IT_FIN;
        if (r < IT_FOUT) { transpose_item(a.in[I_F1WO] + (size_t)l * DFF * D, DFF, D, (bf16*)(wl + WO_F1OUT), nullptr, 0, scr, r, lane); continue; } r -= IT_FOUT;
        if (r < IT_MIN) { transpose_item(a.in[I_MWI] + (size_t)l * D * DIN, D, DIN, (bf16*)(wl + WO_MIN), a.in[I_MN] + l * D, 0, scr, r, lane); continue; } r -= IT_MIN;
        if (r < IT_MOUT) { transpose_item(a.in[I_MWO] + (size_t)l * D * D, D, D, (bf16*)(wl + WO_MOUT), nullptr, 0, scr, r, lane); continue; } r -= IT_MOUT;
        if (r < IT_FIN) { transpose_item(a.in[I_F2WI] + (size_t)l * D * 2 * DFF, D, 2 * DFF, (bf16*)(wl + WO_F2IN), a.in[I_F2N] + l * D, 1, scr, r, lane); continue; } r -= IT_FIN;
        transpose_item(a.in[I_F2WO] + (size_t)l * DFF * D, DFF, D, (bf16*)(wl + WO_F2OUT), nullptr, 0, scr, r, lane);
    }
    const int gt = bid * NT + tid, NGT = G * NT;
    { u32x4* z0 = (u32x4*)(ws + WS_CTL); for (int e = gt; e < (int)(MiB / 16); e += NGT) z0[e] = (u32x4){0u, 0u, 0u, 0u};
      u32x4* z1 = (u32x4*)(ws + WS_SS + (size_t)M * 8); for (int e = gt; e < 6 * M * 8 / 16; e += NGT) z1[e] = (u32x4){0u, 0u, 0u, 0u}; }
    bf16* poolT = (bf16*)(ws + WS_SMALL + SM_POOL); bf16* lruA = (bf16*)(ws + WS_SMALL + SM_LRUA); bf16* lruX = (bf16*)(ws + WS_SMALL + SM_LRUX); bf16* sguW = (bf16*)(ws + WS_SMALL + SM_SGU);
    for (int e = gt; e < DEPTH * 4 * 64 * 64; e += NGT) { const int c = e & 63, d = (e >> 6) & 63, lg = e >> 12; const int src = (lg * 64 + c) * 64 + d;
        poolT[e] = (bf16)f2bf(a.in[I_PW][src]); lruA[e] = (bf16)f2bf(a.in[I_LWA][src]); lruX[e] = (bf16)f2bf(a.in[I_LWX][src]); }
    if (gt < DEPTH * 256) ((float*)(ws + WS_SMALL + SM_SPL))[gt] = log1pf(__expf(-a.in[I_LAM][gt]));
    for (int e = gt; e < DEPTH * 4 * 128 * 128; e += NGT) { const int s = e & 127, t = (e >> 7) & 127; sguW[e] = (s <= t) ? (bf16)f2bf(a.in[I_SW][e]) : (bf16)0; }
    bf16* XB = (bf16*)(ws + WS_XB); pg8::ssq_t* ss0 = (pg8::ssq_t*)(ws + WS_SS);
    for (int m = gw; m < M; m += 4 * NGW) {
        f32x4 v[4][4];
#pragma unroll
        for (int q = 0; q < 4; ++q) { const f32x4* xr = (const f32x4*)(a.in[I_X] + (size_t)(m + q * NGW) * D) + lane;
#pragma unroll
            for (int j = 0; j < 4; ++j) v[q][j] = xr[64 * j]; }
#pragma unroll
        for (int q = 0; q < 4; ++q) { float s = 0.f;
#pragma unroll
            for (int j = 0; j < 4; ++j) s += (v[q][j].x * v[q][j].x + v[q][j].y * v[q][j].y) + (v[q][j].z * v[q][j].z + v[q][j].w * v[q][j].w);
            s = wave_sum(s);
            u32x2* o = (u32x2*)(XB + (size_t)(m + q * NGW) * D) + lane;
#pragma unroll
            for (int j = 0; j < 4; ++j) { u32x2 w; w.x = pk2(v[q][j].x, v[q][j].y); w.y = pk2(v[q][j].z, v[q][j].w); o[64 * j] = w; }
            if (lane == 0) ss0[m + q * NGW] = pg8::ssq_from_float(s); }
    }
}

__device__ __forceinline__ void final_norm(const Args& a, int G, int bid, int wave, int lane) {
    asm volatile("" : "+v"(lane));
    const int gw = bid * NWAVES + wave, NGW = G * NWAVES; const pg8::ssq_t* ss = (const pg8::ssq_t*)(a.ws + WS_SS) + 6 * M; const f32x4* gf = (const f32x4*)a.in[I_FN] + lane;
    const bf16* XB = (const bf16*)(a.ws + WS_XB);
    f32x4 g[4];
#pragma unroll
    for (int j = 0; j < 4; ++j) g[j] = gf[64 * j];
    for (int m = gw; m < M; m += NGW) {
        const u32x2* xr = (const u32x2*)(XB + (size_t)m * D) + lane; f32x4* orow = (f32x4*)(a.out + (size_t)m * D) + lane;
        const float rs = __builtin_amdgcn_rsqf(pg8::ssq_to_float(ss[m]) * (1.0f / 1024.0f) + pg8::RMS_EPS);
        u32x2 w[4];
#pragma unroll
        for (int j = 0; j < 4; ++j) w[j] = xr[64 * j];
#pragma unroll
        for (int j = 0; j < 4; ++j) { f32x4 v = (f32x4){bf2f(w[j].x & 0xffffu), bf2f(w[j].x >> 16), bf2f(w[j].y & 0xffffu), bf2f(w[j].y >> 16)}; orow[64 * j] = v * rs * g[j]; }
    }
}

#define MFMA16(a, b, c) __builtin_amdgcn_mfma_f32_16x16x32_bf16((a), (b), (c), 0, 0, 0)
#define WG_BAR() __syncthreads()

__device__ __forceinline__ void pool_loop(const Args& a, int l, int bid, int G, LAS unsigned char* lds, int tid, int wave, int lane) {
    asm volatile("" : "+v"(tid)); lane = tid & 63; asm volatile("" : "+s"(bid));
    const bf16* P = (const bf16*)(a.ws + WS_ACT); bf16* Y = (bf16*)(a.ws + WS_Y);
    const bf16* poolT = (const bf16*)(a.ws + WS_SMALL + SM_POOL) + l * 4 * 64 * 64;
    const float* scale = a.in[I_PS] + l * 256;
    constexpr int XS = 264;
    LAS bf16* XP = (LAS bf16*)lds;
    LAS bf16* DD = (LAS bf16*)(lds + 80 * XS * 2);
    int item = bid; if (item >= 512) return;
    const int gw = wave >> 1, half = wave & 1, r = lane & 15, qd = lane >> 4;
    bf16x8 af[2][4]; f32x4 scv[4];
#pragma unroll
    for (int ks = 0; ks < 2; ++ks)
#pragma unroll
        for (int mt = 0; mt < 4; ++mt) af[ks][mt] = *(const bf16x8*)(poolT + (gw * 64 + mt * 16 + r) * 64 + ks * 32 + 8 * qd);
#pragma unroll
    for (int mt = 0; mt < 4; ++mt) scv[mt] = *(const f32x4*)(scale + gw * 64 + mt * 16 + 4 * qd);
    u32x4 xr[5];
#define POOL_LOAD(it_) do { const int b_ = (it_) >> 6, t0_ = ((it_) & 63) * 64; \
        _Pragma("unroll") for (int i = 0; i < 5; ++i) { const int p = tid + i * NT; const int rr = p >> 5, c16 = p & 31, t = t0_ - 16 + rr; xr[i] = (u32x4){0u, 0u, 0u, 0u}; \
            if (t >= 0) xr[i] = *(const u32x4*)(P + (size_t)(b_ * SEQ + t) * DIN + c16 * 8); } } while (0)
    POOL_LOAD(item);
    for (;;) {
    const int b = item >> 6, t0 = (item & 63) * 64;
#pragma unroll
    for (int i = 0; i < 5; ++i) { const int p = tid + i * NT; *(LAS u32x4*)(XP + (p >> 5) * XS + (p & 31) * 8) = xr[i]; }
    const int nitem = item + G; const bool more = nitem < 512;
    if (more) POOL_LOAD(nitem);
    WG_BAR();
    {
      const int cp = tid & 127, g = cp >> 5, tq = tid >> 7;
      float p0[32], p1[32]; p0[0] = 0.f; p1[0] = 0.f;
      unsigned xw[31];
#pragma unroll
      for (int i = 0; i < 31; ++i) xw[i] = *(const LAS unsigned*)(XP + (1 + 16 * tq + i) * XS + 2 * cp);
#pragma unroll
      for (int i = 0; i < 31; ++i) { p0[i + 1] = p0[i] + bf2f(xw[i] & 0xffffu); p1[i + 1] = p1[i] + bf2f(xw[i] >> 16); }
#pragma unroll
      for (int k = 0; k < 16; ++k) { const int tk = 16 * tq + k;
          const float a0 = g == 0 ? p0[14 + k] : (g == 1 ? p0[12 + k] : (g == 2 ? p0[8 + k] : p0[k]));
          const float a1 = g == 0 ? p1[14 + k] : (g == 1 ? p1[12 + k] : (g == 2 ? p1[8 + k] : p1[k]));
          const int win = 2 << g; const int cnt = min(t0 + tk + 1, win); const float inv = 1.0f / (float)cnt;
          *(LAS unsigned*)(DD + tk * XS + 2 * cp) = pk2((p0[16 + k] - a0) * inv - bf2f(xw[15 + k] & 0xffffu), (p1[16 + k] - a1) * inv - bf2f(xw[15 + k] >> 16)); } }
    WG_BAR();
    { f32x4 acc[4][2];
#pragma unroll
      for (int mt = 0; mt < 4; ++mt)
#pragma unroll
          for (int nt = 0; nt < 2; ++nt) acc[mt][nt] = (f32x4){0.f, 0.f, 0.f, 0.f};
#pragma unroll
      for (int ks = 0; ks < 2; ++ks) {
          bf16x8 bfr[2];
#pragma unroll
          for (int nt = 0; nt < 2; ++nt) bfr[nt] = *(const LAS bf16x8*)(DD + (half * 32 + nt * 16 + r) * XS + gw * 64 + ks * 32 + 8 * qd);
#pragma unroll
          for (int mt = 0; mt < 4; ++mt)
#pragma unroll
              for (int nt = 0; nt < 2; ++nt) acc[mt][nt] = MFMA16(af[ks][mt], bfr[nt], acc[mt][nt]);
      }
#pragma unroll
      for (int mt = 0; mt < 4; ++mt) { const int dc = gw * 64 + mt * 16 + 4 * qd; const f32x4 sc = scv[mt];
#pragma unroll
          for (int nt = 0; nt < 2; ++nt) { const int t = t0 + half * 32 + nt * 16 + r; const f32x4 v = acc[mt][nt] * sc;
              u32x2 w; w.x = pk2(v[0], v[1]); w.y = pk2(v[2], v[3]); *(u32x2*)(Y + (size_t)(b * SEQ + t) * D + dc) = w; } }
    }
    WG_BAR();
    if (!more) break;
    item = nitem;
    }
#undef POOL_LOAD
}

__device__ __forceinline__ void sgu_item(const Args& a, int l, int item, LAS unsigned char* lds, int tid, int wave, int lane) {
    asm volatile("" : "+v"(tid)); lane = tid & 63;
    const bf16* P = (const bf16*)(a.ws + WS_ACT); bf16* Y = (bf16*)(a.ws + WS_Y);
    const bf16* sguW = (const bf16*)(a.ws + WS_SMALL + SM_SGU) + l * 4 * 128 * 128;
    const float* sgub = a.in[I_SB] + l * 4 * 128;
    const size_t row0 = (size_t)item * 128;
    constexpr int VS = 136;
    LAS bf16* VN = (LAS bf16*)lds;
    const int h2 = wave >> 1, th2 = wave & 1, r2 = lane & 15, qd2 = lane >> 4;
    u32x2 uw[4][4]; float biasv[4]; bf16x8 wpre[2][4];
#pragma unroll
    for (int nt = 0; nt < 4; ++nt) { const int t = th2 * 64 + nt * 16 + r2; biasv[nt] = sgub[h2 * 128 + t];
#pragma unroll
        for (int mt = 0; mt < 4; ++mt) uw[nt][mt] = *(const u32x2*)(P + (row0 + t) * DIN + 1024 + h2 * 64 + mt * 16 + 4 * qd2); }
#pragma unroll
    for (int ks = 0; ks < 2; ++ks)
#pragma unroll
        for (int nt = 0; nt < 4; ++nt) wpre[ks][nt] = *(const bf16x8*)(sguW + (h2 * 128 + th2 * 64 + nt * 16 + r2) * 128 + ks * 32 + 8 * qd2);
    { const int h = wave >> 1, tok = (wave & 1) * 64 + lane;
      const u32x4* src = (const u32x4*)(P + (row0 + tok) * DIN + 1280 + h * 64);
      float v[64]; float s = 0.f;
#pragma unroll
      for (int j = 0; j < 8; ++j) { const u32x4 w = src[j];
#pragma unroll
          for (int k = 0; k < 4; ++k) { const float x0 = gelu_tanh(bf2f(w[k] & 0xffffu)), x1 = gelu_tanh(bf2f(w[k] >> 16)); v[8 * j + 2 * k] = x0; v[8 * j + 2 * k + 1] = x1; s += x0 + x1; } }
      const float mu = s * (1.0f / 64.0f); float q = 0.f;
#pragma unroll
      for (int c = 0; c < 64; ++c) { v[c] -= mu; q += v[c] * v[c]; }
      const float rs = __builtin_amdgcn_rsqf(q * (1.0f / 64.0f) + 1e-6f);
#pragma unroll
      for (int c = 0; c < 64; ++c) VN[(h * 64 + c) * VS + tok] = (bf16)f2bf(v[c] * rs);
    }
    WG_BAR();
    { const int h = wave >> 1, th = wave & 1, r = lane & 15, qd = lane >> 4;
      f32x4 acc[4][4];
#pragma unroll
      for (int mt = 0; mt < 4; ++mt)
#pragma unroll
          for (int nt = 0; nt < 4; ++nt) acc[mt][nt] = (f32x4){0.f, 0.f, 0.f, 0.f};
      const int nks = 2 + 2 * th;
      bf16x8 wlate[2][4];
      if (th) {
#pragma unroll
          for (int ks = 0; ks < 2; ++ks)
#pragma unroll
              for (int nt = 0; nt < 4; ++nt) wlate[ks][nt] = *(const bf16x8*)(sguW + (h * 128 + th * 64 + nt * 16 + r) * 128 + (ks + 2) * 32 + 8 * qd);
      }
#pragma unroll
      for (int ks = 0; ks < 4; ++ks) { if (ks < nks) {
          bf16x8 af[4], bfr[4];
#pragma unroll
          for (int mt = 0; mt < 4; ++mt) af[mt] = *(const LAS bf16x8*)(VN + (h * 64 + mt * 16 + r) * VS + ks * 32 + 8 * qd);
#pragma unroll
          for (int nt = 0; nt < 4; ++nt) bfr[nt] = ks < 2 ? wpre[ks & 1][nt] : wlate[ks & 1][nt];
#pragma unroll
          for (int mt = 0; mt < 4; ++mt)
#pragma unroll
              for (int nt = 0; nt < 4; ++nt) acc[mt][nt] = MFMA16(af[mt], bfr[nt], acc[mt][nt]);
      } }
#pragma unroll
      for (int nt = 0; nt < 4; ++nt) { const int t = th * 64 + nt * 16 + r; const float bias = biasv[nt];
#pragma unroll
          for (int mt = 0; mt < 4; ++mt) { const int c = h * 64 + mt * 16 + 4 * qd;
              const u32x2 uq = uw[nt][mt];
              const float u0 = gelu_tanh(bf2f(uq.x & 0xffffu)), u1 = gelu_tanh(bf2f(uq.x >> 16)), u2 = gelu_tanh(bf2f(uq.y & 0xffffu)), u3 = gelu_tanh(bf2f(uq.y >> 16));
              u32x2 w; w.x = pk2(u0 * (acc[mt][nt][0] + bias), u1 * (acc[mt][nt][1] + bias)); w.y = pk2(u2 * (acc[mt][nt][2] + bias), u3 * (acc[mt][nt][3] + bias));
              *(u32x2*)(Y + (row0 + t) * D + 512 + c) = w; } }
    }
    WG_BAR();
}

template <bool MASKED>
__device__ __forceinline__ void sb_block(const bf16x8 (&kf)[2][2], const bf16x8 (&vf)[4], const bf16x8 (&qf)[2], int kb, int tq, int n, int qd, float& carry, f32x4 (&O)[4], bool& done) {
    f32x4 s[2];
#pragma unroll
    for (int tt = 0; tt < 2; ++tt) { s[tt] = (f32x4){0.f, 0.f, 0.f, 0.f}; s[tt] = MFMA16(kf[tt][0], qf[0], s[tt]); s[tt] = MFMA16(kf[tt][1], qf[1], s[tt]); }
    float beta[8], keep[8];
#pragma unroll
    for (int j = 0; j < 8; ++j) { const float t = fminf(s[j >> 2][j & 3] * (-0.125f * 1.4426950408889634f), 100.0f);
        const float e = __builtin_amdgcn_exp2f(t); float bb = __builtin_amdgcn_rcpf(1.0f + e); float kp = e * bb;
        if (MASKED) { const bool valid = (kb + 8 * qd + j) < tq; bb = valid ? bb : 0.f; kp = valid ? kp : 1.f; }
        beta[j] = bb; keep[j] = kp; }
    float suf[8]; float run = 1.f;
#pragma unroll
    for (int j = 7; j >= 0; --j) { suf[j] = run; run *= keep[j]; }
    const float T0 = __shfl(run, n), T1 = __shfl(run, n + 16), T2 = __shfl(run, n + 32), T3 = __shfl(run, n + 48);
    const float hi = (qd < 1 ? T1 : 1.f) * (qd < 2 ? T2 : 1.f) * (qd < 3 ? T3 : 1.f);
    const float base = hi * carry;
    float av[8];
#pragma unroll
    for (int j = 0; j < 8; ++j) av[j] = beta[j] * suf[j] * base;
    carry *= (T0 * T1) * (T2 * T3);
    u32x4 pw; pw.x = pk2(av[0], av[1]); pw.y = pk2(av[2], av[3]); pw.z = pk2(av[4], av[5]); pw.w = pk2(av[6], av[7]);
    const bf16x8 pf = __builtin_bit_cast(bf16x8, pw);
#pragma unroll
    for (int dt = 0; dt < 4; ++dt) O[dt] = MFMA16(vf[dt], pf, O[dt]);
    if (__all(carry < 1.17549435e-38f)) done = true;
}
__device__ __forceinline__ void sb_loop(const Args& a, int bid, int G, LAS unsigned char* lds, int tid, int wave, int lane) {
    asm volatile("" : "+v"(tid)); lane = tid & 63; asm volatile("" : "+s"(bid));
    const bf16* P = (const bf16*)(a.ws + WS_ACT); bf16* Y = (bf16*)(a.ws + WS_Y); const bf16* Vt = (const bf16*)(a.ws + WS_VT);
    const int n = lane & 15, qd = lane >> 4;
    constexpr int KS = 72, VS2 = 328;
    LAS bf16* KL = (LAS bf16*)lds;
    LAS bf16* VL = KL + 320 * KS;
    const int krow = 8 * (n >> 2) + (n & 3);
    int j = bid; if (j >= 1024) return;
    u32x4 kr[5], vr[5]; bf16x8 qn[2];
#define SB_LOAD(jj) do { const int qb_ = 31 - ((jj) & 31), bh_ = (jj) >> 5, b_ = bh_ >> 2, h_ = bh_ & 3; const int q0_ = qb_ * 128, ks0_ = max(0, q0_ - 192), nk_ = q0_ + 128 - ks0_, nkc_ = nk_ >> 3; \
        const bf16* Pb_ = P + (size_t)b_ * SEQ * DIN; const bf16* Vh_ = Vt + (size_t)(b_ * 256 + h_ * 64) * SEQ; \
        _Pragma("unroll") for (int ks = 0; ks < 2; ++ks) qn[ks] = *(const bf16x8*)(Pb_ + (size_t)(q0_ + 16 * wave + n) * DIN + 256 + h_ * 64 + ks * 32 + 8 * qd); \
        _Pragma("unroll") for (int i = 0; i < 5; ++i) { const int p = tid + i * NT; kr[i] = (u32x4){0u, 0u, 0u, 0u}; if (p < nk_ * 8) kr[i] = *(const u32x4*)(Pb_ + (size_t)(ks0_ + (p >> 3)) * DIN + 512 + h_ * 64 + (p & 7) * 8); } \
        _Pragma("unroll") for (int i = 0; i < 5; ++i) { const int p = tid + i * NT; const int d = (nk_ == 320) ? p / 40 : (nk_ == 256 ? (p >> 5) : (p >> 4)), c = p - d * nkc_; vr[i] = (u32x4){0u, 0u, 0u, 0u}; \
            if (p < 64 * nkc_) vr[i] = *(const u32x4*)(Vh_ + (size_t)d * SEQ + ks0_ + c * 8); } } while (0)
    SB_LOAD(j);
    for (;;) {
        const int qb = 31 - (j & 31), bh = j >> 5, b = bh >> 2, h = bh & 3;
        const bf16* Pb = P + (size_t)b * SEQ * DIN; const bf16* Vh = Vt + (size_t)(b * 256 + h * 64) * SEQ;
        const int q0 = qb * 128, ks0 = max(0, q0 - 192), nk = q0 + 128 - ks0, nkc = nk >> 3;
        const int q0w = q0 + 16 * wave, tq = q0w + n;
        bf16x8 qf[2]; qf[0] = qn[0]; qf[1] = qn[1];
#pragma unroll
        for (int i = 0; i < 5; ++i) { const int p = tid + i * NT; if (p < nk * 8) *(LAS u32x4*)(KL + (p >> 3) * KS + (p & 7) * 8) = kr[i]; }
#pragma unroll
        for (int i = 0; i < 5; ++i) { const int p = tid + i * NT; const int d = (nk == 320) ? p / 40 : (nk == 256 ? (p >> 5) : (p >> 4)), c = p - d * nkc; if (p < 64 * nkc) *(LAS u32x4*)(VL + d * VS2 + c * 8) = vr[i]; }
        const int jn = j + G; const bool more = jn < 1024;
        if (more) SB_LOAD(jn);
        WG_BAR();
        float carry = 1.f; bool done = false;
        f32x4 O[4];
#pragma unroll
        for (int dt = 0; dt < 4; ++dt) O[dt] = (f32x4){0.f, 0.f, 0.f, 0.f};
        int kb = (q0w + 14) & ~31;
        { const int lk0 = kb - ks0;
          bf16x8 kf[2][2], vf[4];
#pragma unroll
          for (int tt = 0; tt < 2; ++tt)
#pragma unroll
              for (int ks = 0; ks < 2; ++ks) kf[tt][ks] = *(const LAS bf16x8*)(KL + (lk0 + krow + 4 * tt) * KS + ks * 32 + 8 * qd);
#pragma unroll
          for (int dt = 0; dt < 4; ++dt) vf[dt] = *(const LAS bf16x8*)(VL + (dt * 16 + n) * VS2 + lk0 + 8 * qd);
          sb_block<true>(kf, vf, qf, kb, tq, n, qd, carry, O, done); kb -= 32; }
        for (; kb >= ks0 && !done; kb -= 32) {
            const int lk0 = kb - ks0;
            bf16x8 kf[2][2], vf[4];
#pragma unroll
            for (int tt = 0; tt < 2; ++tt)
#pragma unroll
                for (int ks = 0; ks < 2; ++ks) kf[tt][ks] = *(const LAS bf16x8*)(KL + (lk0 + krow + 4 * tt) * KS + ks * 32 + 8 * qd);
#pragma unroll
            for (int dt = 0; dt < 4; ++dt) vf[dt] = *(const LAS bf16x8*)(VL + (dt * 16 + n) * VS2 + lk0 + 8 * qd);
            sb_block<false>(kf, vf, qf, kb, tq, n, qd, carry, O, done);
        }
        for (; kb >= 0 && !done; kb -= 32) {
            bf16x8 kf[2][2], vf[4];
#pragma unroll
            for (int tt = 0; tt < 2; ++tt)
#pragma unroll
                for (int ks = 0; ks < 2; ++ks) kf[tt][ks] = *(const bf16x8*)(Pb + (size_t)(kb + krow + 4 * tt) * DIN + 512 + h * 64 + ks * 32 + 8 * qd);
#pragma unroll
            for (int dt = 0; dt < 4; ++dt) vf[dt] = *(const bf16x8*)(Vh + (size_t)(dt * 16 + n) * SEQ + kb + 8 * qd);
            sb_block<false>(kf, vf, qf, kb, tq, n, qd, carry, O, done);
        }
#pragma unroll
        for (int dt = 0; dt < 4; ++dt) { u32x2 w; w.x = pk2(O[dt][0], O[dt][1]); w.y = pk2(O[dt][2], O[dt][3]);
            *(u32x2*)(Y + (size_t)(b * SEQ + q0w + n) * D + 256 + h * 64 + dt * 16 + 4 * qd) = w; }
        WG_BAR();
        if (!more) break;
        j = jn;
    }
#undef SB_LOAD
}

__device__ __forceinline__ void lruA_loop(const Args& a, int l, int bid, int G, LAS unsigned char* lds, int tid, int wave, int lane) {
    asm volatile("" : "+v"(tid)); lane = tid & 63; asm volatile("" : "+s"(bid));
    const bf16* P = (const bf16*)(a.ws + WS_ACT);
    bf16* Y = (bf16*)(a.ws + WS_Y); float* SUM = (float*)(a.ws + WS_SUM) + (size_t)l * (8 * 32 * 2 * 256); unsigned* FLG = (unsigned*)(a.ws + WS_CTL) + CW_FLG + l * 1024;
    int item = bid; if (item >= 1024) return;
    int g = item & 3, b = (item >> 2) & 7, chunk = item >> 5, t0 = chunk * 128;
    constexpr int AS = 68, XCS = 72;
    LAS float* A_ = (LAS float*)lds;
    LAS float* B_ = A_ + 128 * AS;
    LAS bf16* XC = (LAS bf16*)(B_ + 128 * AS);
    LAS bf16* XR = XC + 128 * XCS;
    LAS bf16* GG = XR + 131 * 64;
    LAS float* PH = (LAS float*)(GG + 128 * 64);
    const int cpair = tid & 31, r = lane & 15, qd = lane >> 4;
    u32x4 px[3], pg[2];
#define LRUA_LOAD(bb, gg, tt0) do { const bf16* Px_ = P + (size_t)(bb) * SEQ * DIN + 1536 + (gg) * 64; const bf16* Pg_ = Px_ + 256; \
        _Pragma("unroll") for (int i = 0; i < 3; ++i) { const int p = tid + i * NT; const int rr = p >> 3, c8 = p & 7, t = (tt0) - 3 + rr; px[i] = (u32x4){0u, 0u, 0u, 0u}; \
            if (p < 131 * 8 && t >= 0) px[i] = *(const u32x4*)(Px_ + (size_t)t * DIN + c8 * 8); } \
        _Pragma("unroll") for (int i = 0; i < 2; ++i) { const int p = tid + i * NT; const int rr = p >> 3, c8 = p & 7; pg[i] = *(const u32x4*)(Pg_ + (size_t)((tt0) + rr) * DIN + c8 * 8); } } while (0)
    LRUA_LOAD(b, g, t0);
    float cw[4][2], cb[2];
#define LRUA_CONVW(gg) do { const float* convw = a.in[I_CW] + l * 4 * 256 + (gg) * 64; const float* convb = a.in[I_CB] + l * 256 + (gg) * 64; \
        _Pragma("unroll") for (int w = 0; w < 4; ++w) { cw[w][0] = convw[w * 256 + 2 * cpair]; cw[w][1] = convw[w * 256 + 2 * cpair + 1]; } \
        cb[0] = convb[2 * cpair]; cb[1] = convb[2 * cpair + 1]; } while (0)
    LRUA_CONVW(g);
    for (;;) {
#pragma unroll
    for (int i = 0; i < 3; ++i) { const int p = tid + i * NT; if (p < 131 * 8) *(LAS u32x4*)(XR + p * 8) = px[i]; }
#pragma unroll
    for (int i = 0; i < 2; ++i) { const int p = tid + i * NT; *(LAS u32x4*)(GG + p * 8) = pg[i]; }
    const int nitem = item + G; const bool more = nitem < 1024;
    const int ng = nitem & 3, nb = (nitem >> 2) & 7, nchunk = nitem >> 5;
    const bf16* wA = (const bf16*)(a.ws + WS_SMALL + SM_LRUA) + (l * 4 + g) * 64 * 64;
    const bf16* wX = (const bf16*)(a.ws + WS_SMALL + SM_LRUX) + (l * 4 + g) * 64 * 64;
    const float* ba = a.in[I_LBA] + l * 256 + g * 64; const float* bx = a.in[I_LBX] + l * 256 + g * 64; const float* lam = (const float*)(a.ws + WS_SMALL + SM_SPL) + l * 256 + g * 64;
    bf16x8 fa[2][4], fx[2][4];
#pragma unroll
    for (int ks = 0; ks < 2; ++ks)
#pragma unroll
        for (int mt = 0; mt < 4; ++mt) { fa[ks][mt] = *(const bf16x8*)(wA + (mt * 16 + r) * 64 + ks * 32 + 8 * qd); fx[ks][mt] = *(const bf16x8*)(wX + (mt * 16 + r) * 64 + ks * 32 + 8 * qd); }
    f32x4 vba[4], vbx[4], vlam[4];
#pragma unroll
    for (int mt = 0; mt < 4; ++mt) { const int d0 = mt * 16 + 4 * qd; vba[mt] = *(const f32x4*)(ba + d0); vbx[mt] = *(const f32x4*)(bx + d0); vlam[mt] = *(const f32x4*)(lam + d0); }
    if (more) LRUA_LOAD(nb, ng, nchunk * 128);
    WG_BAR();
#pragma unroll
    for (int i = 0; i < 8; ++i) { const int t = (tid >> 5) + 16 * i; float x0 = cb[0], x1 = cb[1];
#pragma unroll
        for (int w = 0; w < 4; ++w) { const unsigned v = *(const LAS unsigned*)(XR + (t + w) * 64 + 2 * cpair); x0 += cw[w][0] * bf2f(v & 0xffffu); x1 += cw[w][1] * bf2f(v >> 16); }
        *(LAS unsigned*)(XC + t * XCS + 2 * cpair) = pk2(x0, x1); }
    WG_BAR();
    { f32x4 ra[4], ri[4];
#pragma unroll
      for (int mt = 0; mt < 4; ++mt) { ra[mt] = (f32x4){0.f, 0.f, 0.f, 0.f}; ri[mt] = (f32x4){0.f, 0.f, 0.f, 0.f}; }
#pragma unroll
      for (int ks = 0; ks < 2; ++ks) { const bf16x8 xf = *(const LAS bf16x8*)(XC + (wave * 16 + r) * XCS + ks * 32 + 8 * qd);
#pragma unroll
          for (int mt = 0; mt < 4; ++mt) { ra[mt] = MFMA16(fa[ks][mt], xf, ra[mt]); ri[mt] = MFMA16(fx[ks][mt], xf, ri[mt]); } }
      const int t = wave * 16 + r;
#pragma unroll
      for (int mt = 0; mt < 4; ++mt) { const int d0 = mt * 16 + 4 * qd;
          const u32x2 xw = *(const LAS u32x2*)(XC + t * XCS + d0);
          const float xc[4] = {bf2f(xw.x & 0xffffu), bf2f(xw.x >> 16), bf2f(xw.y & 0xffffu), bf2f(xw.y >> 16)};
          f32x4 av, bv;
#pragma unroll
          for (int i = 0; i < 4; ++i) { const float rr = sigmoidf_(ra[mt][i] + vba[mt][i]), ii = sigmoidf_(ri[mt][i] + vbx[mt][i]);
              const float sp = vlam[mt][i];
              const float la = -8.0f * rr * sp; const float x2 = 2.0f * la;
              const float aa = __expf(la);
              float om;
              if (x2 > -0.25f) om = -x2 * (1.0f + x2 * (0.5f + x2 * (0.16666667f + x2 * (0.041666668f + x2 * (0.0083333338f + x2 * 0.0013888889f))))); else om = 1.0f - __expf(x2);
              av[i] = aa; bv[i] = __builtin_sqrtf(om) * ii * xc[i]; }
          *(LAS f32x4*)(A_ + t * AS + d0) = av; *(LAS f32x4*)(B_ + t * AS + d0) = bv; }
    }
    WG_BAR();
    { float Pp = 1.f, H = 0.f;
#pragma unroll
      for (int k = 0; k < 16; ++k) { const float aa = A_[(wave * 16 + k) * AS + lane], bb = B_[(wave * 16 + k) * AS + lane]; H = aa * H + bb; Pp *= aa; }
      PH[(wave * 64 + lane) * 2] = Pp; PH[(wave * 64 + lane) * 2 + 1] = H; }
    WG_BAR();
    { float ch = 0.f, cp = 1.f, hin = 0.f, pin = 1.f;
#pragma unroll
      for (int w = 0; w < 8; ++w) { if (w == wave) { hin = ch; pin = cp; } const float pw = PH[(w * 64 + lane) * 2], hw = PH[(w * 64 + lane) * 2 + 1]; ch = pw * ch + hw; cp *= pw; }
      if (wave == 7) { float* sp = SUM + ((size_t)(b * 32 + chunk) * 2) * 256 + g * 64 + lane; sp[0] = cp; sp[256] = ch;
          __builtin_amdgcn_fence(__ATOMIC_RELEASE, "agent"); asm volatile("s_waitcnt vmcnt(0)" ::: "memory");
          if (lane == 0) __hip_atomic_store(FLG + (b * 4 + g) * 32 + chunk, 1u, __ATOMIC_RELAXED, __HIP_MEMORY_SCOPE_AGENT); }
      if (wave == 0 && chunk > 0) { unsigned spins = 0;
          for (;;) { unsigned v = 1u; if (lane < chunk) v = __hip_atomic_load(FLG + (b * 4 + g) * 32 + lane, __ATOMIC_RELAXED, __HIP_MEMORY_SCOPE_AGENT);
              if (__all(v != 0u)) break; __builtin_amdgcn_s_sleep(2); if (++spins > (1u << 22)) break; }
          __builtin_amdgcn_fence(__ATOMIC_ACQUIRE, "agent"); asm volatile("s_waitcnt vmcnt(0)" ::: "memory"); }
      WG_BAR();
      float c = 0.f;
      { const float* sp = SUM + ((size_t)(b * 32) * 2) * 256 + g * 64 + lane;
        float pj[31], hj[31];
#pragma unroll
        for (int j = 0; j < 31; ++j) { pj[j] = 1.f; hj[j] = 0.f; if (j < chunk) { pj[j] = sp[(size_t)j * 512]; hj[j] = sp[(size_t)j * 512 + 256]; } }
#pragma unroll
        for (int j = 0; j < 31; ++j) c = pj[j] * c + hj[j]; }
      float hcur = pin * c + hin;
#pragma unroll
      for (int k = 0; k < 16; ++k) { const int t = wave * 16 + k; const float aa = A_[t * AS + lane], bb = B_[t * AS + lane]; hcur = aa * hcur + bb;
          const float gv = gelu_tanh(bf2f((unsigned)GG[t * 64 + lane]));
          Y[(size_t)(b * SEQ + t0 + t) * D + 768 + g * 64 + lane] = (bf16)f2bf(hcur * gv); }
    }
    WG_BAR();
    if (!more) break;
    if (ng != g) { g = ng; LRUA_CONVW(g); }
    item = nitem; chunk = nchunk; b = nb; t0 = nchunk * 128;
    }
#undef LRUA_LOAD
#undef LRUA_CONVW
}
__device__ __forceinline__ void mixer_part(const Args& a, int part, int l, int bid, int G, LAS unsigned char* lds, int tid, int wave, int lane) {
    asm volatile("" : "+s"(bid));
    constexpr int N_SGU = 256;
    lruA_loop(a, l, bid, G, lds, tid, wave, lane);
    for (int it = bid; it < N_SGU; it += G) sgu_item(a, l, it, lds, tid, wave, lane);
    pool_loop(a, l, bid, G, lds, tid, wave, lane);
    sb_loop(a, bid, G, lds, tid, wave, lane);
}

#define XB_TMO      128
#define XB_XCNT(j)  (256  + 64 * (j))
#define XB_XSUB(j)  (1280 + 64 * (j))
#define XB_XGEN(j)  (2304 + 64 * (j))
#define XB_TOP      3328
#define XB_TOPGEN   3392
#define XCD_BAR_WORDS 3456
#define XB_SPIN_CAP (1u << 22)

__device__ __forceinline__ unsigned xb_ld(unsigned* p)              { return __hip_atomic_load(p, __ATOMIC_RELAXED, __HIP_MEMORY_SCOPE_AGENT); }
__device__ __forceinline__ unsigned xb_add(unsigned* p, unsigned v) { return __hip_atomic_fetch_add(p, v, __ATOMIC_RELAXED, __HIP_MEMORY_SCOPE_AGENT); }
__device__ __forceinline__ unsigned xb_xcc_id() { return (unsigned)__builtin_amdgcn_s_getreg((3 << 11) | 20) & 0xFu; }
#define XB_SPIN(cond, bar) do { unsigned _sp = 0; while (cond) { __builtin_amdgcn_s_sleep(1); \
    if ((++_sp & 255u) == 0u) { if (xb_ld(&(bar)[XB_TMO])) break; if (_sp > XB_SPIN_CAP) { atomicAdd(&(bar)[XB_TMO], 1u); break; } } } } while (0)

struct XcdBarrier {
    unsigned* bar; unsigned x;
    volatile LAS unsigned* st;
};

__device__ __forceinline__ XcdBarrier xcd_barrier_post(unsigned* bar, volatile LAS unsigned* st) {
    XcdBarrier b; b.bar = bar; b.x = xb_xcc_id(); b.st = st;
    if (threadIdx.x == 0) (void)xb_add(&bar[XB_XCNT(b.x)], 1u);
    return b;
}
__device__ __forceinline__ void xcd_barrier_complete(unsigned* bar, unsigned x, unsigned& nloc, unsigned& nx) {
    const unsigned G = gridDim.x * gridDim.y * gridDim.z;
    unsigned sum, cnt, mine, sp = 0u;
    for (;;) {
        sum = 0u; cnt = 0u; mine = 0u;
#pragma unroll
        for (unsigned j = 0; j < 16; ++j) { const unsigned c = xb_ld(&bar[XB_XCNT(j)]); sum += c; cnt += (c > 0u) ? 1u : 0u; mine = (j == x) ? c : mine; }
        if (sum == G) break;
        __builtin_amdgcn_s_sleep(1);
        if ((++sp & 255u) == 0u) { if (xb_ld(&bar[XB_TMO])) break; if (sp > XB_SPIN_CAP) { atomicAdd(&bar[XB_TMO], 1u); break; } }
    }
    nloc = mine > 0u ? mine : 1u; nx = cnt > 0u ? cnt : 1u;
}

__device__ __forceinline__ void xcd_barrier(const XcdBarrier& b) {
    asm volatile("s_waitcnt vmcnt(0)" ::: "memory");
    __syncthreads();
    if (threadIdx.x == 0) {
        unsigned* bar = b.bar;
        __builtin_amdgcn_s_waitcnt(0);
        unsigned nloc = b.st[0], nx = b.st[1];
        if (nloc == 0u) { xcd_barrier_complete(bar, b.x, nloc, nx); b.st[0] = nloc; b.st[1] = nx; }
        const unsigned old = xb_add(&bar[XB_XSUB(b.x)], 1u);
        const unsigned gen = old / nloc;
        if (old + 1u == (gen + 1u) * nloc) {
            __builtin_amdgcn_fence(__ATOMIC_RELEASE, "agent");
            asm volatile("s_waitcnt vmcnt(0)" ::: "memory");
            const unsigned og = xb_add(&bar[XB_TOP], 1u);
            const unsigned tg = og / nx;
            if (og + 1u == (tg + 1u) * nx) xb_add(&bar[XB_TOPGEN], 1u);
            else XB_SPIN(xb_ld(&bar[XB_TOPGEN]) == tg, bar);
            __builtin_amdgcn_fence(__ATOMIC_ACQUIRE, "agent");
            xb_add(&bar[XB_XGEN(b.x)], 1u);
            asm volatile("s_waitcnt vmcnt(0)" ::: "memory");
        } else {
            XB_SPIN(xb_ld(&bar[XB_XGEN(b.x)]) == gen, bar);
            __builtin_amdgcn_fence(__ATOMIC_ACQUIRE, "agent");
            asm volatile("s_waitcnt vmcnt(0)" ::: "memory");
        }
    }
    __syncthreads();
}

__global__ void __launch_bounds__(NT, 2) fwd_kernel(Args a) {
    extern __shared__ __attribute__((aligned(16))) unsigned char lds_raw[];
    LAS unsigned char* lds = (LAS unsigned char*)lds_raw;
    const int tid = threadIdx.x, lane = tid & 63, wave = __builtin_amdgcn_readfirstlane(tid >> 6);
    const int G = gridDim.x, bid = blockIdx.x;
    unsigned char* ws = a.ws;
    const int lo = a.ph_lo, hi = a.ph_hi;
    pg8::ssq_t* ssbase = (pg8::ssq_t*)(ws + WS_SS);
    bf16* XB = (bf16*)(ws + WS_XB); bf16* YB = (bf16*)(ws + WS_Y); bf16* ACT = (bf16*)(ws + WS_ACT); bf16* VT = (bf16*)(ws + WS_VT);
    volatile LAS unsigned* bst = (volatile LAS unsigned*)(lds + RING_BYTES + 64);
    if (tid < 2) bst[tid] = 0u;
    __syncthreads();
    XcdBarrier bar; bar.bar = (unsigned*)(ws + WS_CTL) + CW_BAR; bar.x = 0; bar.st = bst;
#define SEAM() do { if (hi - lo > 1) xcd_barrier(bar); } while (0)
    int ph = 0;
    if (lo <= ph && ph < hi) { for (int rep = 0; rep < REP_PRO; ++rep) { prologue(a, lds, G, bid, wave, lane, tid); __syncthreads(); if (hi - lo > 1) cg::this_grid().sync(); } }
    if (hi - lo > 1) bar = xcd_barrier_post((unsigned*)(ws + WS_CTL) + CW_BAR, bst);
    ++ph;
#pragma unroll 1
    for (int st = 0; st < 7 * DEPTH; ++st) {
        const int l = st / 7, k = st - 7 * l;
        unsigned char* wl = ws + WS_W + l * W_LAYER;
        if (k == 0 || k == 5) {
            pg8::Gemm g{XB, (const bf16*)(wl + (k == 0 ? WO_F1IN : WO_F2IN)), M, 2 * DFF, D}; pg8::StaticOrder S; S.init(M, 2 * DFF, G, bid);
            pg8::EpiSwiGLU E{ACT, ssbase + (3 * l + (k == 0 ? 0 : 2)) * M, DFF}; pg8::gemm_phase<pg8::EpiSwiGLU, pg8::StaticOrder, true, true>(lds, g, S, E);
        } else if (k == 1 || k == 4 || k == 6) {
            const bf16* Ap = (k == 4) ? YB : ACT; const int Kk = (k == 4) ? D : DFF;
            const bf16* Bp = (const bf16*)(wl + (k == 1 ? WO_F1OUT : (k == 4 ? WO_MOUT : WO_F2OUT)));
            pg8::Gemm g{Ap, Bp, M, D, Kk}; pg8::StaticOrder S; S.init(M, D, G, bid);
            pg8::EpiResidual E{nullptr, XB, ssbase + (3 * l + (k == 1 ? 1 : (k == 4 ? 2 : 3))) * M, (k == 4) ? 1.0f : 0.5f};
            pg8::gemm_phase<pg8::EpiResidual, pg8::StaticOrder, true, true>(lds, g, S, E);
        } else if (k == 2) {
            pg8::Gemm g{XB, (const bf16*)(wl + WO_MIN), M, DIN, D}; pg8::StaticOrder S; S.init(M, DIN, G, bid);
            pg8::EpiMixIn E{ACT, ssbase + (3 * l + 1) * M, VT}; pg8::gemm_phase<pg8::EpiMixIn, pg8::StaticOrder, true, true>(lds, g, S, E);
        } else {
            mixer_part(a, 0, l, bid, G, lds, tid, wave, lane);
        }
        SEAM();
    }
    ph += 7 * DEPTH;
    if (lo <= ph && ph < hi) final_norm(a, G, bid, wave, lane);
}
constexpr int N_PHASES = 2 + 7 * DEPTH;

#ifndef MK_MULTI
#define MK_MULTI 0
#endif
extern "C" void kernel_launch(void* const* d_in, const int* in_sizes, int n_in, void* d_out, int out_size, void* d_ws, size_t ws_size, hipStream_t stream) {
    static int grid = 0;
    if (grid == 0) {
        if (n_in != 22 || in_sizes[0] != M * D || out_size != M * D || ws_size < WS_END) { fprintf(stderr, "kernel_launch: unexpected shapes/workspace (n_in %d, ws %zu)\n", n_in, ws_size); grid = -1; return; }
        int dev = 0, cus = 0, per_cu = 0;
        hipGetDevice(&dev); hipDeviceGetAttribute(&cus, hipDeviceAttributeMultiprocessorCount, dev);
        if (hipFuncSetAttribute((const void*)fwd_kernel, hipFuncAttributeMaxDynamicSharedMemorySize, LDS_BYTES) != hipSuccess) { fprintf(stderr, "kernel_launch: hipFuncSetAttribute failed\n"); grid = -1; return; }
        hipOccupancyMaxActiveBlocksPerMultiprocessor(&per_cu, (const void*)fwd_kernel, NT, LDS_BYTES);
        (void)hipGetLastError();
        if (per_cu < 1) per_cu = 1;
        grid = cus * 1;
    }
    if (grid < 0) return;
    Args a{};
    for (int i = 0; i < 22; ++i) a.in[i] = (const float*)d_in[i];
    a.out = (float*)d_out; a.ws = (unsigned char*)d_ws;
#if MK_MULTI
    for (int p = 0; p < N_PHASES; ++p) { a.ph_lo = p; a.ph_hi = p + 1; hipLaunchKernelGGL(fwd_kernel, dim3(grid), dim3(NT), LDS_BYTES, stream, a); }
#else
    a.ph_lo = 0; a.ph_hi = N_PHASES;
    void* args[] = {&a};
    hipError_t e = hipLaunchCooperativeKernel((const void*)fwd_kernel, dim3(grid), dim3(NT), args, LDS_BYTES, stream);
    if (e != hipSuccess) fprintf(stderr, "cooperative launch failed: %s (grid %d)\n", hipGetErrorString(e), grid);
#endif
}
```

```cpp
#include <hip/hip_runtime.h>
#include <hip/hip_cooperative_groups.h>
#include <cstdio>
#include <cstdint>
namespace cg = cooperative_groups;
namespace pg8 {
#define PG8_LAS __attribute__((address_space(3)))
typedef unsigned short bf16_t;
typedef short bf16x8 __attribute__((ext_vector_type(8)));
typedef float f32x4 __attribute__((ext_vector_type(4)));
typedef unsigned u32x4 __attribute__((ext_vector_type(4)));
constexpr int BM = 256, BK = 64, HALF = 128, HTB = HALF * BK * 2  , STAGE_BYTES = 8 * HTB, NXCD = 8, WGM = 8;

__host__ __device__ __forceinline__ int lds_byte(int r, int c) { const int st = (r >> 4) * 2 + (c >> 5), rr = r & 15, cc = c & 31, ob = rr * 64 + cc * 2; return st * 1024 + (ob ^ (((ob >> 9) & 1) << 5)); }
__host__ __device__ __forceinline__ void stage_rc(int b, int& R, int& C) { const int st = b / 1024, sb = b % 1024, swz = sb ^ (((sb >> 9) & 1) << 5); R = (st >> 1) * 16 + swz / 64; C = (st & 1) * 32 + (swz % 64) / 2; }
__host__ __device__ __forceinline__ int perm32(int rho) { const int n = rho >> 4, i = rho & 15; return 8 * (i >> 2) + 4 * n + (i & 3); }

struct Unit { int pm, pn; };
struct Gemm { const bf16_t* A; const bf16_t* Bt; int M, N, K; };

struct StaticOrder {
    int nM, nN, nwg, G, c;
    __host__ __device__ void init(int M, int N, int G_, int c_) { nM = M / BM; nN = N / BM; nwg = nM * nN; G = G_; c = c_; }
    __host__ __device__ bool next(int i, Unit& u) const {
        const long L = (long)i * G + c; if (L >= nwg) return false;
        int wgid = (int)L; { const int q = nwg / NXCD, r = nwg % NXCD, xcd = wgid % NXCD, off = wgid / NXCD; wgid = (xcd < r ? xcd * (q + 1) : r * (q + 1) + (xcd - r) * q) + off; }
        const int nig = WGM * nN, gid = wgid / nig, fm = gid * WGM, gsz = (nM - fm) < WGM ? (nM - fm) : WGM;
        u.pm = fm + ((wgid % nig) % gsz); u.pn = (wgid % nig) / gsz; return true;
    }
    __device__ __forceinline__ void a_ready(const Unit&) const {}
    __device__ __forceinline__ void done(const Unit&) const {}
};

__device__ __forceinline__ unsigned cvt_pk_bf16(float lo, float hi) { unsigned r; asm volatile("v_cvt_pk_bf16_f32 %0, %1, %2" : "=v"(r) : "v"(lo), "v"(hi)); return r; }
template <class Epi, class Sched, bool ALIGN_EPI = false, bool SP2 = false>
__device__ __forceinline__ void gemm_phase(PG8_LAS unsigned char* lds, const Gemm g, const Sched& S, const Epi& E) {
    int tid_ = threadIdx.x; asm volatile("" : "+v"(tid_));
    const int tid = tid_, wid = __builtin_amdgcn_readfirstlane(tid >> 6), lane = tid & 63, wr = wid >> 2, wc = wid & 3, fr = lane & 15, fq = lane >> 4;
    const int K = g.K, nt = K / BK;
    unsigned voffA[2], voffB[2];
#pragma unroll
    for (int i = 0; i < 2; ++i) { int R, C; stage_rc(tid * 16 + i * 8192, R, C); const int Rb = Epi::PERM ? ((R & ~31) + perm32(R & 31)) : R;
        voffA[i] = (unsigned)(R * K + C) * 2u; voffB[i] = (unsigned)(Rb * K + C) * 2u; }
    const size_t kstep = (size_t)(BK * 2);
    const size_t hstep = (size_t)HALF * K * 2;
    const size_t tstep = 2 * hstep;
    const unsigned ldsw = (unsigned)wid * 1024u;
    const int aoff = lds_byte(wr * 64 + fr, fq * 8), boff = lds_byte(wc * 32 + fr, fq * 8);
#define PG8_SA(b, h) (((b) * 2 + (h)) * HTB)
#define PG8_SB(b, h) ((4 + (b) * 2 + (h)) * HTB)
#define PG8_STAGE(bufoff, gbase, voff) do { _Pragma("unroll") for (int _i = 0; _i < 2; ++_i) \
        __builtin_amdgcn_global_load_lds((const unsigned*)((const char*)(gbase) + (voff)[_i]), (PG8_LAS unsigned*)(lds + (bufoff) + ldsw + _i * 8192), 16, 0, 0); } while (0)
#define PG8_LDA(dst, b, h) do { _Pragma("unroll") for (int m = 0; m < 4; ++m) _Pragma("unroll") for (int k = 0; k < 2; ++k) dst[m][k] = *(const PG8_LAS bf16x8*)(lds + PG8_SA(b, h) + aoff + m * 2048 + k * 1024); } while (0)
#define PG8_LDB(dst, b, h) do { _Pragma("unroll") for (int n = 0; n < 2; ++n) _Pragma("unroll") for (int k = 0; k < 2; ++k) dst[n][k] = *(const PG8_LAS bf16x8*)(lds + PG8_SB(b, h) + boff + n * 2048 + k * 1024); } while (0)
#define PG8_MMA(ai, bj, At, Bt) do { __builtin_amdgcn_s_setprio(1); _Pragma("unroll") for (int m = 0; m < 4; ++m) _Pragma("unroll") for (int n = 0; n < 2; ++n) _Pragma("unroll") for (int k = 0; k < 2; ++k) \
        acc[ai][bj][m][n] = __builtin_amdgcn_mfma_f32_16x16x32_bf16(Bt[n][k], At[m][k], acc[ai][bj][m][n], 0, 0, 0); __builtin_amdgcn_s_setprio(0); } while (0)
#define PG8_WAIT_V(n) asm volatile("s_waitcnt vmcnt(" #n ")" ::: "memory")
#define PG8_WAIT_L(n) asm volatile("s_waitcnt lgkmcnt(" #n ")" ::: "memory")
#define PG8_BAR __builtin_amdgcn_s_barrier()
#define PG8_SCHED __builtin_amdgcn_sched_barrier(0)
    Unit cur, nxt; int ui = 0;
    if (!S.next(0, cur)) return;
    Epi Ee = E;
    Ee.prefetch(cur, wr, fr);
    f32x4 acc[2][2][4][2];
#pragma unroll
    for (int a = 0; a < 2; ++a)
#pragma unroll
        for (int b = 0; b < 2; ++b)
#pragma unroll
            for (int m = 0; m < 4; ++m)
#pragma unroll
                for (int n = 0; n < 2; ++n) acc[a][b][m][n] = (f32x4){0.f, 0.f, 0.f, 0.f};
    bf16x8 At[4][2], B0[2][2], B1[2][2];
    const char* cA = (const char*)g.A + (size_t)cur.pm * tstep; const char* cB = (const char*)g.Bt + (size_t)cur.pn * tstep;
    S.a_ready(cur);
    if constexpr (SP2) {
        PG8_STAGE(PG8_SB(0, 0), cB, voffB); PG8_STAGE(PG8_SB(0, 1), cB + hstep, voffB); PG8_STAGE(PG8_SA(0, 0), cA, voffA); PG8_STAGE(PG8_SA(0, 1), cA + hstep, voffA);
        if (wr == 1) PG8_BAR;
        PG8_WAIT_V(2); PG8_BAR;
        PG8_STAGE(PG8_SB(1, 0), cB + kstep, voffB); PG8_STAGE(PG8_SA(1, 0), cA + kstep, voffA); PG8_STAGE(PG8_SB(1, 1), cB + hstep + kstep, voffB);
        PG8_WAIT_V(6); PG8_BAR;
    } else {
        PG8_STAGE(PG8_SB(0, 0), cB, voffB); PG8_STAGE(PG8_SA(0, 0), cA, voffA); PG8_STAGE(PG8_SB(0, 1), cB + hstep, voffB); PG8_STAGE(PG8_SA(0, 1), cA + hstep, voffA);
        if (wr == 1) PG8_BAR;
        PG8_WAIT_V(4); PG8_BAR;
        PG8_STAGE(PG8_SB(1, 0), cB + kstep, voffB); PG8_STAGE(PG8_SA(1, 0), cA + kstep, voffA); PG8_STAGE(PG8_SB(1, 1), cB + hstep + kstep, voffB);
        PG8_WAIT_V(6); PG8_BAR;
    }
    for (;;) {
        const bool has_next = S.next(ui + 1, nxt);
        const char* nA = has_next ? (const char*)g.A + (size_t)nxt.pm * tstep : cA; const char* nB = has_next ? (const char*)g.Bt + (size_t)nxt.pn * tstep : cB;
        for (int t = 0; t < nt; t += 2) {
            const bool last = (t == nt - 2);
            const char* a1 = cA + (size_t)(t + 1) * kstep;
            const char* a2 = last ? nA : cA + (size_t)(t + 2) * kstep; const char* b2 = last ? nB : cB + (size_t)(t + 2) * kstep;
            const char* a3 = a2 + kstep; const char* b3 = b2 + kstep;
            if (last && has_next) S.a_ready(nxt);
            if constexpr (SP2) {
            PG8_LDB(B0, 0, 0); PG8_LDB(B1, 0, 1); PG8_SCHED; PG8_LDA(At, 0, 0); PG8_STAGE(PG8_SA(1, 1), a1 + hstep, voffA);
            PG8_WAIT_V(8); PG8_WAIT_L(0); PG8_BAR; PG8_MMA(0, 0, At, B0); PG8_MMA(0, 1, At, B1); PG8_BAR; PG8_SCHED;
            PG8_LDA(At, 0, 1); PG8_STAGE(PG8_SB(0, 0), b2, voffB); PG8_STAGE(PG8_SB(0, 1), b2 + hstep, voffB); PG8_STAGE(PG8_SA(0, 0), a2, voffA);
            PG8_WAIT_V(8); PG8_WAIT_L(0); PG8_BAR; PG8_MMA(1, 0, At, B0); PG8_MMA(1, 1, At, B1); PG8_BAR; PG8_SCHED;
            PG8_LDB(B0, 1, 0); PG8_LDB(B1, 1, 1); PG8_SCHED; PG8_LDA(At, 1, 0); PG8_STAGE(PG8_SA(0, 1), a2 + hstep, voffA);
            PG8_WAIT_V(8); PG8_WAIT_L(0); PG8_BAR; PG8_MMA(0, 0, At, B0); PG8_MMA(0, 1, At, B1); PG8_BAR; PG8_SCHED;
            PG8_LDA(At, 1, 1); PG8_STAGE(PG8_SB(1, 0), b3, voffB); PG8_STAGE(PG8_SB(1, 1), b3 + hstep, voffB); PG8_STAGE(PG8_SA(1, 0), a3, voffA);
            PG8_WAIT_V(8); PG8_WAIT_L(0); PG8_BAR; PG8_MMA(1, 0, At, B0); PG8_MMA(1, 1, At, B1); PG8_BAR; PG8_SCHED;
            } else {
            PG8_LDB(B0, 0, 0); PG8_SCHED; PG8_LDA(At, 0, 0); PG8_STAGE(PG8_SA(1, 1), a1 + hstep, voffA);
            PG8_WAIT_L(8); PG8_BAR; PG8_WAIT_L(0); PG8_MMA(0, 0, At, B0); PG8_BAR; PG8_SCHED;
            PG8_LDB(B1, 0, 1); PG8_STAGE(PG8_SB(0, 0), b2, voffB);
            PG8_BAR; PG8_WAIT_L(0); PG8_MMA(0, 1, At, B1); PG8_BAR;
            PG8_LDA(At, 0, 1); PG8_STAGE(PG8_SA(0, 0), a2, voffA);
            PG8_BAR; PG8_WAIT_L(0); PG8_MMA(1, 0, At, B0); PG8_BAR; PG8_SCHED;
            PG8_STAGE(PG8_SB(0, 1), b2 + hstep, voffB);
            PG8_WAIT_V(6); PG8_BAR; PG8_MMA(1, 1, At, B1); PG8_BAR;
            PG8_LDB(B0, 1, 0); PG8_SCHED; PG8_LDA(At, 1, 0); PG8_STAGE(PG8_SA(0, 1), a2 + hstep, voffA);
            PG8_WAIT_L(8); PG8_BAR; PG8_WAIT_L(0); PG8_MMA(0, 0, At, B0); PG8_BAR; PG8_SCHED;
            PG8_LDB(B1, 1, 1); PG8_STAGE(PG8_SB(1, 0), b3, voffB);
            PG8_BAR; PG8_WAIT_L(0); PG8_MMA(0, 1, At, B1); PG8_BAR;
            PG8_LDA(At, 1, 1); PG8_STAGE(PG8_SA(1, 0), a3, voffA);
            PG8_BAR; PG8_WAIT_L(0); PG8_MMA(1, 0, At, B0); PG8_BAR; PG8_SCHED;
            PG8_STAGE(PG8_SB(1, 1), b3 + hstep, voffB);
            PG8_WAIT_V(6); PG8_BAR; PG8_MMA(1, 1, At, B1); PG8_BAR;
            }
        }
        if constexpr (ALIGN_EPI) { if (wr == 0) PG8_BAR; }
        if constexpr (!Epi::AFTER_DRAIN) { Ee(acc, cur, wr, wc, fr, fq); S.done(cur); if (has_next) Ee.prefetch(nxt, wr, fr); }
        if (!has_next) break;
#pragma unroll
        for (int a = 0; a < 2; ++a)
#pragma unroll
            for (int b = 0; b < 2; ++b)
#pragma unroll
                for (int m = 0; m < 4; ++m)
#pragma unroll
                    for (int n = 0; n < 2; ++n) acc[a][b][m][n] = (f32x4){0.f, 0.f, 0.f, 0.f};
        cur = nxt; cA = nA; cB = nB; ++ui;
        if constexpr (ALIGN_EPI) { if (wr == 1) PG8_BAR; }
    }
    PG8_WAIT_V(0);
    if constexpr (!ALIGN_EPI) { if (wr == 0) PG8_BAR; }
    PG8_BAR;
    if constexpr (Epi::AFTER_DRAIN) { Ee.fused(acc, cur, wr, wc, fr, fq, lds, wid, lane); S.done(cur); }
#undef PG8_SA
#undef PG8_SB
#undef PG8_STAGE
#undef PG8_LDA
#undef PG8_LDB
#undef PG8_MMA
#undef PG8_WAIT_V
#undef PG8_WAIT_L
#undef PG8_BAR
#undef PG8_SCHED
}
}
namespace pg8 {
constexpr float RMS_EPS = 1e-6f;
typedef unsigned long long ssq_t;
constexpr float SSQ_SCALE = 1048576.0f, SSQ_INV = 1.0f / 1048576.0f;
__device__ __forceinline__ ssq_t ssq_from_float(float s) { return (ssq_t)__float2ull_rn(s * SSQ_SCALE); }
__device__ __forceinline__ float ssq_to_float(ssq_t v) { return (float)v * SSQ_INV; }
typedef float f32x2 __attribute__((ext_vector_type(2)));
__device__ __forceinline__ float fast_sigmoid(float x) { return __builtin_amdgcn_rcpf(1.0f + __builtin_amdgcn_exp2f(-1.4426950408889634f * x)); }
struct EpiSwiGLU {
    static constexpr bool PERM = true, AFTER_DRAIN = false;
    bf16_t* O; const ssq_t* ss; int ldo; ssq_t rsq8[2][4];
    __device__ __forceinline__ void prefetch(const Unit& u, int wr, int fr) { const int row0 = u.pm * BM + wr * 64 + fr;
#pragma unroll
        for (int ai = 0; ai < 2; ++ai)
#pragma unroll
            for (int m = 0; m < 4; ++m) rsq8[ai][m] = ss[row0 + ai * HALF + m * 16]; }
    __device__ __forceinline__ void operator()(const f32x4 (&acc)[2][2][4][2], const Unit& u, int wr, int wc, int fr, int fq) const {
        const int row0 = u.pm * BM + wr * 64 + fr, col0 = u.pn * 128 + wc * 32 + 8 * fq;
        float rsv[2][4];
#pragma unroll
        for (int ai = 0; ai < 2; ++ai)
#pragma unroll
            for (int m = 0; m < 4; ++m) rsv[ai][m] = ssq_to_float(rsq8[ai][m]);
#pragma unroll
        for (int ai = 0; ai < 2; ++ai)
#pragma unroll
            for (int m = 0; m < 4; ++m) {
                const int row = row0 + ai * HALF + m * 16;
                const float rs = __builtin_amdgcn_rsqf(rsv[ai][m] * (1.0f / 1024.0f) + RMS_EPS);
                const float rsn = rs * -1.4426950408889634f, rsq = rs * rs;
                float o[8];
#pragma unroll
                for (int n = 0; n < 2; ++n)
#pragma unroll
                    for (int i = 0; i < 4; i += 2) { const f32x2 g2 = (f32x2){acc[ai][0][m][n][i], acc[ai][0][m][n][i + 1]}, u2 = (f32x2){acc[ai][1][m][n][i], acc[ai][1][m][n][i + 1]};
                        const f32x2 t2 = g2 * rsn; f32x2 e2; e2.x = __builtin_amdgcn_exp2f(t2.x); e2.y = __builtin_amdgcn_exp2f(t2.y);
                        const f32x2 d2 = e2 + 1.0f; f32x2 r2; r2.x = __builtin_amdgcn_rcpf(d2.x); r2.y = __builtin_amdgcn_rcpf(d2.y);
                        const f32x2 o2 = ((g2 * u2) * rsq) * r2; o[4 * n + i] = o2.x; o[4 * n + i + 1] = o2.y; }
                u32x4 w; w.x = cvt_pk_bf16(o[0], o[1]); w.y = cvt_pk_bf16(o[2], o[3]); w.z = cvt_pk_bf16(o[4], o[5]); w.w = cvt_pk_bf16(o[6], o[7]);
                *(u32x4*)(O + (size_t)row * ldo + col0) = w;
            }
    }
};
struct EpiMixIn {
    static constexpr bool PERM = true, AFTER_DRAIN = false;
    bf16_t* O; const ssq_t* ss; bf16_t* Vt; ssq_t rsq8[2][4];
    __device__ __forceinline__ void prefetch(const Unit& u, int wr, int fr) { const int row0 = u.pm * BM + wr * 64 + fr;
#pragma unroll
        for (int ai = 0; ai < 2; ++ai)
#pragma unroll
            for (int m = 0; m < 4; ++m) rsq8[ai][m] = ss[row0 + ai * HALF + m * 16]; }
    __device__ __forceinline__ void operator()(const f32x4 (&acc)[2][2][4][2], const Unit& u, int wr, int wc, int fr, int fq) const {
        const int row0 = u.pm * BM + wr * 64 + fr;
        float rsv[2][4];
#pragma unroll
        for (int ai = 0; ai < 2; ++ai)
#pragma unroll
            for (int m = 0; m < 4; ++m) rsv[ai][m] = ssq_to_float(rsq8[ai][m]);
#pragma unroll
        for (int ai = 0; ai < 2; ++ai)
#pragma unroll
            for (int m = 0; m < 4; ++m) {
                const int row = row0 + ai * HALF + m * 16;
                const float rs = __builtin_amdgcn_rsqf(rsv[ai][m] * (1.0f / 1024.0f) + RMS_EPS);
#pragma unroll
                for (int bj = 0; bj < 2; ++bj) {
                    const f32x4 v0 = acc[ai][bj][m][0] * rs, v1 = acc[ai][bj][m][1] * rs;
                    if (u.pn != 3) {
                        u32x4 w; w.x = cvt_pk_bf16(v0[0], v0[1]); w.y = cvt_pk_bf16(v0[2], v0[3]); w.z = cvt_pk_bf16(v1[0], v1[1]); w.w = cvt_pk_bf16(v1[2], v1[3]);
                        *(u32x4*)(O + (size_t)row * 2048 + u.pn * BM + bj * HALF + wc * 32 + 8 * fq) = w;
                    } else {
                        const int b = row >> 12, s = row & 4095, cl = bj * HALF + wc * 32 + 8 * fq;
                        bf16_t* vp = Vt + ((size_t)(b * 256 + cl) * 4096 + s);
                        const unsigned w0 = cvt_pk_bf16(v0[0], v0[1]), w1 = cvt_pk_bf16(v0[2], v0[3]), w2 = cvt_pk_bf16(v1[0], v1[1]), w3 = cvt_pk_bf16(v1[2], v1[3]);
                        vp[0 * 4096] = (bf16_t)(w0 & 0xffffu); vp[1 * 4096] = (bf16_t)(w0 >> 16); vp[2 * 4096] = (bf16_t)(w1 & 0xffffu); vp[3 * 4096] = (bf16_t)(w1 >> 16);
                        vp[4 * 4096] = (bf16_t)(w2 & 0xffffu); vp[5 * 4096] = (bf16_t)(w2 >> 16); vp[6 * 4096] = (bf16_t)(w3 & 0xffffu); vp[7 * 4096] = (bf16_t)(w3 >> 16);
                    }
                }
            }
    }
};
struct EpiResidual {
    static constexpr bool PERM = true, AFTER_DRAIN = false;
    const float* Xin32; bf16_t* XB; ssq_t* ssn; float alpha;
    __device__ __forceinline__ void prefetch(const Unit&, int, int) {}
    __device__ __forceinline__ void operator()(const f32x4 (&acc)[2][2][4][2], const Unit& u, int wr, int wc, int fr, int fq) const {
        const int row0 = u.pm * BM + wr * 64 + fr, col0 = u.pn * BM + wc * 32 + 8 * fq;
        u32x4 xw[2][4][2];
#pragma unroll
        for (int ai = 0; ai < 2; ++ai)
#pragma unroll
            for (int m = 0; m < 4; ++m)
#pragma unroll
                for (int bj = 0; bj < 2; ++bj) xw[ai][m][bj] = *(const u32x4*)(XB + (size_t)(row0 + ai * HALF + m * 16) * 1024 + col0 + bj * HALF);
#pragma unroll
        for (int ai = 0; ai < 2; ++ai) {
#pragma unroll
            for (int m = 0; m < 4; ++m) {
                const int row = row0 + ai * HALF + m * 16; float s = 0.f;
#pragma unroll
                for (int bj = 0; bj < 2; ++bj) {
                    const size_t off = (size_t)row * 1024 + col0 + bj * HALF;
                    const u32x4 w0 = xw[ai][m][bj];
                    const f32x4 x0 = (f32x4){__uint_as_float(w0.x << 16), __uint_as_float(w0.x & 0xffff0000u), __uint_as_float(w0.y << 16), __uint_as_float(w0.y & 0xffff0000u)};
                    const f32x4 x1 = (f32x4){__uint_as_float(w0.z << 16), __uint_as_float(w0.z & 0xffff0000u), __uint_as_float(w0.w << 16), __uint_as_float(w0.w & 0xffff0000u)};
                    const f32x4 v0 = x0 + acc[ai][bj][m][0] * alpha, v1 = x1 + acc[ai][bj][m][1] * alpha;
                    u32x4 w; w.x = cvt_pk_bf16(v0[0], v0[1]); w.y = cvt_pk_bf16(v0[2], v0[3]); w.z = cvt_pk_bf16(v1[0], v1[1]); w.w = cvt_pk_bf16(v1[2], v1[3]);
                    *(u32x4*)(XB + off) = w;
                    s += (v0[0] * v0[0] + v0[1] * v0[1]) + (v0[2] * v0[2] + v0[3] * v0[3]) + (v1[0] * v1[0] + v1[1] * v1[1]) + (v1[2] * v1[2] + v1[3] * v1[3]);
                }
                s += __shfl_xor(s, 16); s += __shfl_xor(s, 32);
                if (fq == 0) atomicAdd(ssn + row, ssq_from_float(s));
            }
        }
    }
};
struct EpiNone { static constexpr bool PERM = true, AFTER_DRAIN = false; float* sink;
    __device__ __forceinline__ void prefetch(const Unit&, int, int) {}
    __device__ __forceinline__ void operator()(const f32x4 (&acc)[2][2][4][2], const Unit& u, int wr, int wc, int fr, int fq) const { f32x4 t = (f32x4){0.f, 0.f, 0.f, 0.f};
#pragma unroll
        for (int a = 0; a < 2; ++a)
#pragma unroll
            for (int b = 0; b < 2; ++b)
#pragma unroll
                for (int m = 0; m < 4; ++m)
#pragma unroll
                    for (int n = 0; n < 2; ++n) t += acc[a][b][m][n];
        if (t[0] + t[1] + t[2] + t[3] == 1.2345e-30f) sink[0] = t[0]; } };
}

#define LAS __attribute__((address_space(3)))
typedef unsigned short bf16;
typedef float f32x4 __attribute__((ext_vector_type(4)));
typedef short bf16x8 __attribute__((ext_vector_type(8)));
typedef unsigned u32x4 __attribute__((ext_vector_type(4)));
typedef unsigned u32x2 __attribute__((ext_vector_type(2)));
constexpr int NWAVES = 8, NT = 512;
constexpr int BATCH = 8, SEQ = 4096, D = 1024, M = BATCH * SEQ, DFF = 2816, DIN = 2048, DEPTH = 2;
constexpr size_t MiB = 1u << 20;
constexpr size_t WS_CTL = 0, WS_SS = 1 * MiB, WS_SMALL = 3 * MiB, WS_W = 4 * MiB, W_LAYER = 39 * MiB;
constexpr size_t WO_F1IN = 0, WO_F1OUT = 11 * MiB, WO_MIN = 16 * MiB + MiB / 2, WO_MOUT = 20 * MiB + MiB / 2, WO_F2IN = 22 * MiB + MiB / 2, WO_F2OUT = 33 * MiB + MiB / 2;
constexpr size_t WS_XB = 84 * MiB, WS_Y = 148 * MiB, WS_VT = 212 * MiB, WS_ACT = 228 * MiB, WS_EF = 404 * MiB, WS_SUM = 468 * MiB, WS_END = 469 * MiB;
constexpr size_t SM_POOL = 0, SM_LRUA = 64 * 1024, SM_LRUX = 128 * 1024, SM_SGU = 192 * 1024, SM_SPL = 512 * 1024;
constexpr int ZERO_BYTES = 3 * (1 << 20);
constexpr int LDS_BYTES = 147456, RING_BYTES = 131072;
#ifndef REP_PRO
#define REP_PRO 1
#endif
#ifndef REP_P0
#define REP_P0 1
#endif
#ifndef REP_P1
#define REP_P1 1
#endif
#ifndef REP_FIN
#define REP_FIN 1
#endif
constexpr int CW_BAR = 4096;
constexpr int CW_QUEUE = 1024;
constexpr int CW_FLG = 8192;

__device__ __forceinline__ float bf2f(unsigned b) { return __uint_as_float(b << 16); }
__device__ __forceinline__ unsigned f2bf(float f) { unsigned u = __float_as_uint(f); return (u + 0x7fffu + ((u >> 16) & 1u)) >> 16; }
__device__ __forceinline__ unsigned pk2(float lo, float hi) { return pg8::cvt_pk_bf16(lo, hi); }
__device__ __forceinline__ float sigmoidf_(float x) { return __builtin_amdgcn_rcpf(1.0f + __builtin_amdgcn_exp2f(-1.4426950408889634f * x)); }
__device__ __forceinline__ float gelu_tanh(float x) { const float u2 = 1.5957691216057308f * (x + 0.044715f * x * x * x); return x * sigmoidf_(u2); }
__device__ __forceinline__ float wave_sum(float v) {
#pragma unroll
    for (int o = 1; o < 64; o <<= 1) v += __shfl_xor(v, o);
    return v;
}

struct Args { const float* in[22]; float* out; unsigned char* ws; int ph_lo, ph_hi; };
enum { I_X = 0, I_F1N, I_F1WI, I_F1WO, I_MN, I_MWI, I_MWO, I_PW, I_PS, I_SW, I_SB, I_CW, I_CB, I_LWA, I_LBA, I_LWX, I_LBX, I_LAM, I_F2N, I_F2WI, I_F2WO, I_FN };

__device__ __forceinline__ void transpose_item(const float* W, int K, int N, bf16* WT, const float* gk, int mode, LAS float* scr, int item, int lane) {
    const int nblk = N / 32, kb = item / nblk, nb = item % nblk, k0 = 64 * kb, n0 = 32 * nb;
    { f32x4 v[8]; float gsc[8];
#pragma unroll
      for (int i = 0; i < 8; ++i) { const int kk = 8 * i + (lane >> 3); v[i] = *(const f32x4*)(W + (size_t)(k0 + kk) * N + n0 + 4 * (lane & 7)); gsc[i] = gk ? gk[k0 + kk] : 1.0f; }
#pragma unroll
      for (int i = 0; i < 8; ++i) { const int kk = 8 * i + (lane >> 3); LAS float* d = scr + kk * 33 + 4 * (lane & 7); d[0] = v[i][0] * gsc[i]; d[1] = v[i][1] * gsc[i]; d[2] = v[i][2] * gsc[i]; d[3] = v[i][3] * gsc[i]; } }
    asm volatile("s_waitcnt lgkmcnt(0)" ::: "memory");
    int r0 = n0;
    if (mode == 1) r0 = (n0 < DFF) ? (256 * (n0 / 128) + n0 % 128) : (256 * ((n0 - DFF) / 128) + 128 + (n0 - DFF) % 128);
    const int c = lane & 7;
#pragma unroll
    for (int j = 0; j < 4; ++j) { const int n = (lane >> 3) + 8 * j; const LAS float* s = scr + (8 * c) * 33 + n;
        u32x4 o; o.x = pk2(s[0 * 33], s[1 * 33]); o.y = pk2(s[2 * 33], s[3 * 33]); o.z = pk2(s[4 * 33], s[5 * 33]); o.w = pk2(s[6 * 33], s[7 * 33]);
        *(u32x4*)(WT + (size_t)(r0 + n) * K + k0 + 8 * c) = o; }
    asm volatile("s_waitcnt lgkmcnt(0)" ::: "memory");
}

__device__ __forceinline__ void prologue(const Args& a, LAS unsigned char* lds, int G, int bid, int wave, int lane, int tid) {
    asm volatile("" : "+v"(tid)); lane = tid & 63;
    unsigned char* ws = a.ws;
    LAS float* scr = (LAS float*)(lds + wave * 16384);
    const int gw = bid * NWAVES + wave, NGW = G * NWAVES;
    constexpr int IT_FIN = (D / 64) * (2 * DFF / 32), IT_FOUT = (DFF / 64) * (D / 32), IT_MIN = (D / 64) * (DIN / 32), IT_MOUT = (D / 64) * (D / 32);
    constexpr int IT_LAYER = 2 * IT_FIN + 2 * IT_FOUT + IT_MIN + IT_MOUT;
    for (int it = gw; it < DEPTH * IT_LAYER; it += NGW) {
        const int l = it / IT_LAYER; int r = it % IT_LAYER; unsigned char* wl = ws + WS_W + l * W_LAYER;
        if (r < IT_FIN) { transpose_item(a.in[I_F1WI] + (size_t)l * D * 2 * DFF, D, 2 * DFF, (bf16*)(wl + WO_F1IN), a.in[I_F1N] + l * D, 1, scr, r, lane); continue; } r -= IT_FIN;
        if (r < IT_FOUT) { transpose_item(a.in[I_F1WO] + (size_t)l * DFF * D, DFF, D, (bf16*)(wl + WO_F1OUT), nullptr, 0, scr, r, lane); continue; } r -= IT_FOUT;
        if (r < IT_MIN) { transpose_item(a.in[I_MWI] + (size_t)l * D * DIN, D, DIN, (bf16*)(wl + WO_MIN), a.in[I_MN] + l * D, 0, scr, r, lane); continue; } r -= IT_MIN;
        if (r < IT_MOUT) { transpose_item(a.in[I_MWO] + (size_t)l * D * D, D, D, (bf16*)(wl + WO_MOUT), nullptr, 0, scr, r, lane); continue; } r -= IT_MOUT;
        if (r < IT_FIN) { transpose_item(a.in[I_F2WI] + (size_t)l * D * 2 * DFF, D, 2 * DFF, (bf16*)(wl + WO_F2IN), a.in[I_F2N] + l * D, 1, scr, r, lane); continue; } r -= IT_FIN;
        transpose_item(a.in[I_F2WO] + (size_t)l * DFF * D, DFF, D, (bf16*)(wl + WO_F2OUT), nullptr, 0, scr, r, lane);
    }
    const int gt = bid * NT + tid, NGT = G * NT;
    { u32x4* z0 = (u32x4*)(ws + WS_CTL); for (int e = gt; e < (int)(MiB / 16); e += NGT) z0[e] = (u32x4){0u, 0u, 0u, 0u};
      u32x4* z1 = (u32x4*)(ws + WS_SS + (size_t)M * 8); for (int e = gt; e < 6 * M * 8 / 16; e += NGT) z1[e] = (u32x4){0u, 0u, 0u, 0u}; }
    bf16* poolT = (bf16*)(ws + WS_SMALL + SM_POOL); bf16* lruA = (bf16*)(ws + WS_SMALL + SM_LRUA); bf16* lruX = (bf16*)(ws + WS_SMALL + SM_LRUX); bf16* sguW = (bf16*)(ws + WS_SMALL + SM_SGU);
    for (int e = gt; e < DEPTH * 4 * 64 * 64; e += NGT) { const int c = e & 63, d = (e >> 6) & 63, lg = e >> 12; const int src = (lg * 64 + c) * 64 + d;
        poolT[e] = (bf16)f2bf(a.in[I_PW][src]); lruA[e] = (bf16)f2bf(a.in[I_LWA][src]); lruX[e] = (bf16)f2bf(a.in[I_LWX][src]); }
    if (gt < DEPTH * 256) ((float*)(ws + WS_SMALL + SM_SPL))[gt] = log1pf(__expf(-a.in[I_LAM][gt]));
    for (int e = gt; e < DEPTH * 4 * 128 * 128; e += NGT) { const int s = e & 127, t = (e >> 7) & 127; sguW[e] = (s <= t) ? (bf16)f2bf(a.in[I_SW][e]) : (bf16)0; }
    bf16* XB = (bf16*)(ws + WS_XB); pg8::ssq_t* ss0 = (pg8::ssq_t*)(ws + WS_SS);
    for (int m = gw; m < M; m += 4 * NGW) {
        f32x4 v[4][4];
#pragma unroll
        for (int q = 0; q < 4; ++q) { const f32x4* xr = (const f32x4*)(a.in[I_X] + (size_t)(m + q * NGW) * D) + lane;
#pragma unroll
            for (int j = 0; j < 4; ++j) v[q][j] = xr[64 * j]; }
#pragma unroll
        for (int q = 0; q < 4; ++q) { float s = 0.f;
#pragma unroll
            for (int j = 0; j < 4; ++j) s += (v[q][j].x * v[q][j].x + v[q][j].y * v[q][j].y) + (v[q][j].z * v[q][j].z + v[q][j].w * v[q][j].w);
            s = wave_sum(s);
            u32x2* o = (u32x2*)(XB + (size_t)(m + q * NGW) * D) + lane;
#pragma unroll
            for (int j = 0; j < 4; ++j) { u32x2 w; w.x = pk2(v[q][j].x, v[q][j].y); w.y = pk2(v[q][j].z, v[q][j].w); o[64 * j] = w; }
            if (lane == 0) ss0[m + q * NGW] = pg8::ssq_from_float(s); }
    }
}

__device__ __forceinline__ void final_norm(const Args& a, int G, int bid, int wave, int lane) {
    asm volatile("" : "+v"(lane));
    const int gw = bid * NWAVES + wave, NGW = G * NWAVES; const pg8::ssq_t* ss = (const pg8::ssq_t*)(a.ws + WS_SS) + 6 * M; const f32x4* gf = (const f32x4*)a.in[I_FN] + lane;
    const bf16* XB = (const bf16*)(a.ws + WS_XB);
    f32x4 g[4];
#pragma unroll
    for (int j = 0; j < 4; ++j) g[j] = gf[64 * j];
    for (int m = gw; m < M; m += NGW) {
        const u32x2* xr = (const u32x2*)(XB + (size_t)m * D) + lane; f32x4* orow = (f32x4*)(a.out + (size_t)m * D) + lane;
        const float rs = __builtin_amdgcn_rsqf(pg8::ssq_to_float(ss[m]) * (1.0f / 1024.0f) + pg8::RMS_EPS);
        u32x2 w[4];
#pragma unroll
        for (int j = 0; j < 4; ++j) w[j] = xr[64 * j];
#pragma unroll
        for (int j = 0; j < 4; ++j) { f32x4 v = (f32x4){bf2f(w[j].x & 0xffffu), bf2f(w[j].x >> 16), bf2f(w[j].y & 0xffffu), bf2f(w[j].y >> 16)}; orow[64 * j] = v * rs * g[j]; }
    }
}

#define MFMA16(a, b, c) __builtin_amdgcn_mfma_f32_16x16x32_bf16((a), (b), (c), 0, 0, 0)
#define WG_BAR() __syncthreads()

__device__ __forceinline__ void pool_loop(const Args& a, int l, int bid, int G, LAS unsigned char* lds, int tid, int wave, int lane) {
    asm volatile("" : "+v"(tid)); lane = tid & 63; asm volatile("" : "+s"(bid));
    const bf16* P = (const bf16*)(a.ws + WS_ACT); bf16* Y = (bf16*)(a.ws + WS_Y);
    const bf16* poolT = (const bf16*)(a.ws + WS_SMALL + SM_POOL) + l * 4 * 64 * 64;
    const float* scale = a.in[I_PS] + l * 256;
    constexpr int XS = 264;
    LAS bf16* XP = (LAS bf16*)lds;
    LAS bf16* DD = (LAS bf16*)(lds + 80 * XS * 2);
    int item = bid; if (item >= 512) return;
    const int gw = wave >> 1, half = wave & 1, r = lane & 15, qd = lane >> 4;
    bf16x8 af[2][4]; f32x4 scv[4];
#pragma unroll
    for (int ks = 0; ks < 2; ++ks)
#pragma unroll
        for (int mt = 0; mt < 4; ++mt) af[ks][mt] = *(const bf16x8*)(poolT + (gw * 64 + mt * 16 + r) * 64 + ks * 32 + 8 * qd);
#pragma unroll
    for (int mt = 0; mt < 4; ++mt) scv[mt] = *(const f32x4*)(scale + gw * 64 + mt * 16 + 4 * qd);
    u32x4 xr[5];
#define POOL_LOAD(it_) do { const int b_ = (it_) >> 6, t0_ = ((it_) & 63) * 64; \
        _Pragma("unroll") for (int i = 0; i < 5; ++i) { const int p = tid + i * NT; const int rr = p >> 5, c16 = p & 31, t = t0_ - 16 + rr; xr[i] = (u32x4){0u, 0u, 0u, 0u}; \
            if (t >= 0) xr[i] = *(const u32x4*)(P + (size_t)(b_ * SEQ + t) * DIN + c16 * 8); } } while (0)
    POOL_LOAD(item);
    for (;;) {
    const int b = item >> 6, t0 = (item & 63) * 64;
#pragma unroll
    for (int i = 0; i < 5; ++i) { const int p = tid + i * NT; *(LAS u32x4*)(XP + (p >> 5) * XS + (p & 31) * 8) = xr[i]; }
    const int nitem = item + G; const bool more = nitem < 512;
    if (more) POOL_LOAD(nitem);
    WG_BAR();
    {
      const int cp = tid & 127, g = cp >> 5, tq = tid >> 7;
      float p0[32], p1[32]; p0[0] = 0.f; p1[0] = 0.f;
      unsigned xw[31];
#pragma unroll
      for (int i = 0; i < 31; ++i) xw[i] = *(const LAS unsigned*)(XP + (1 + 16 * tq + i) * XS + 2 * cp);
#pragma unroll
      for (int i = 0; i < 31; ++i) { p0[i + 1] = p0[i] + bf2f(xw[i] & 0xffffu); p1[i + 1] = p1[i] + bf2f(xw[i] >> 16); }
#pragma unroll
      for (int k = 0; k < 16; ++k) { const int tk = 16 * tq + k;
          const float a0 = g == 0 ? p0[14 + k] : (g == 1 ? p0[12 + k] : (g == 2 ? p0[8 + k] : p0[k]));
          const float a1 = g == 0 ? p1[14 + k] : (g == 1 ? p1[12 + k] : (g == 2 ? p1[8 + k] : p1[k]));
          const int win = 2 << g; const int cnt = min(t0 + tk + 1, win); const float inv = 1.0f / (float)cnt;
          *(LAS unsigned*)(DD + tk * XS + 2 * cp) = pk2((p0[16 + k] - a0) * inv - bf2f(xw[15 + k] & 0xffffu), (p1[16 + k] - a1) * inv - bf2f(xw[15 + k] >> 16)); } }
    WG_BAR();
    { f32x4 acc[4][2];
#pragma unroll
      for (int mt = 0; mt < 4; ++mt)
#pragma unroll
          for (int nt = 0; nt < 2; ++nt) acc[mt][nt] = (f32x4){0.f, 0.f, 0.f, 0.f};
#pragma unroll
      for (int ks = 0; ks < 2; ++ks) {
          bf16x8 bfr[2];
#pragma unroll
          for (int nt = 0; nt < 2; ++nt) bfr[nt] = *(const LAS bf16x8*)(DD + (half * 32 + nt * 16 + r) * XS + gw * 64 + ks * 32 + 8 * qd);
#pragma unroll
          for (int mt = 0; mt < 4; ++mt)
#pragma unroll
              for (int nt = 0; nt < 2; ++nt) acc[mt][nt] = MFMA16(af[ks][mt], bfr[nt], acc[mt][nt]);
      }
#pragma unroll
      for (int mt = 0; mt < 4; ++mt) { const int dc = gw * 64 + mt * 16 + 4 * qd; const f32x4 sc = scv[mt];
#pragma unroll
          for (int nt = 0; nt < 2; ++nt) { const int t = t0 + half * 32 + nt * 16 + r; const f32x4 v = acc[mt][nt] * sc;
              u32x2 w; w.x = pk2(v[0], v[1]); w.y = pk2(v[2], v[3]); *(u32x2*)(Y + (size_t)(b * SEQ + t) * D + dc) = w; } }
    }
    WG_BAR();
    if (!more) break;
    item = nitem;
    }
#undef POOL_LOAD
}

__device__ __forceinline__ void sgu_item(const Args& a, int l, int item, LAS unsigned char* lds, int tid, int wave, int lane) {
    asm volatile("" : "+v"(tid)); lane = tid & 63;
    const bf16* P = (const bf16*)(a.ws + WS_ACT); bf16* Y = (bf16*)(a.ws + WS_Y);
    const bf16* sguW = (const bf16*)(a.ws + WS_SMALL + SM_SGU) + l * 4 * 128 * 128;
    const float* sgub = a.in[I_SB] + l * 4 * 128;
    const size_t row0 = (size_t)item * 128;
    constexpr int VS = 136;
    LAS bf16* VN = (LAS bf16*)lds;
    const int h2 = wave >> 1, th2 = wave & 1, r2 = lane & 15, qd2 = lane >> 4;
    u32x2 uw[4][4]; float biasv[4]; bf16x8 wpre[2][4];
#pragma unroll
    for (int nt = 0; nt < 4; ++nt) { const int t = th2 * 64 + nt * 16 + r2; biasv[nt] = sgub[h2 * 128 + t];
#pragma unroll
        for (int mt = 0; mt < 4; ++mt) uw[nt][mt] = *(const u32x2*)(P + (row0 + t) * DIN + 1024 + h2 * 64 + mt * 16 + 4 * qd2); }
#pragma unroll
    for (int ks = 0; ks < 2; ++ks)
#pragma unroll
        for (int nt = 0; nt < 4; ++nt) wpre[ks][nt] = *(const bf16x8*)(sguW + (h2 * 128 + th2 * 64 + nt * 16 + r2) * 128 + ks * 32 + 8 * qd2);
    { const int h = wave >> 1, tok = (wave & 1) * 64 + lane;
      const u32x4* src = (const u32x4*)(P + (row0 + tok) * DIN + 1280 + h * 64);
      float v[64]; float s = 0.f;
#pragma unroll
      for (int j = 0; j < 8; ++j) { const u32x4 w = src[j];
#pragma unroll
          for (int k = 0; k < 4; ++k) { const float x0 = gelu_tanh(bf2f(w[k] & 0xffffu)), x1 = gelu_tanh(bf2f(w[k] >> 16)); v[8 * j + 2 * k] = x0; v[8 * j + 2 * k + 1] = x1; s += x0 + x1; } }
      const float mu = s * (1.0f / 64.0f); float q = 0.f;
#pragma unroll
      for (int c = 0; c < 64; ++c) { v[c] -= mu; q += v[c] * v[c]; }
      const float rs = __builtin_amdgcn_rsqf(q * (1.0f / 64.0f) + 1e-6f);
#pragma unroll
      for (int c = 0; c < 64; ++c) VN[(h * 64 + c) * VS + tok] = (bf16)f2bf(v[c] * rs);
    }
    WG_BAR();
    { const int h = wave >> 1, th = wave & 1, r = lane & 15, qd = lane >> 4;
      f32x4 acc[4][4];
#pragma unroll
      for (int mt = 0; mt < 4; ++mt)
#pragma unroll
          for (int nt = 0; nt < 4; ++nt) acc[mt][nt] = (f32x4){0.f, 0.f, 0.f, 0.f};
      const int nks = 2 + 2 * th;
      bf16x8 wlate[2][4];
      if (th) {
#pragma unroll
          for (int ks = 0; ks < 2; ++ks)
#pragma unroll
              for (int nt = 0; nt < 4; ++nt) wlate[ks][nt] = *(const bf16x8*)(sguW + (h * 128 + th * 64 + nt * 16 + r) * 128 + (ks + 2) * 32 + 8 * qd);
      }
#pragma unroll
      for (int ks = 0; ks < 4; ++ks) { if (ks < nks) {
          bf16x8 af[4], bfr[4];
#pragma unroll
          for (int mt = 0; mt < 4; ++mt) af[mt] = *(const LAS bf16x8*)(VN + (h * 64 + mt * 16 + r) * VS + ks * 32 + 8 * qd);
#pragma unroll
          for (int nt = 0; nt < 4; ++nt) bfr[nt] = ks < 2 ? wpre[ks & 1][nt] : wlate[ks & 1][nt];
#pragma unroll
          for (int mt = 0; mt < 4; ++mt)
#pragma unroll
              for (int nt = 0; nt < 4; ++nt) acc[mt][nt] = MFMA16(af[mt], bfr[nt], acc[mt][nt]);
      } }
#pragma unroll
      for (int nt = 0; nt < 4; ++nt) { const int t = th * 64 + nt * 16 + r; const float bias = biasv[nt];
#pragma unroll
          for (int mt = 0; mt < 4; ++mt) { const int c = h * 64 + mt * 16 + 4 * qd;
              const u32x2 uq = uw[nt][mt];
              const float u0 = gelu_tanh(bf2f(uq.x & 0xffffu)), u1 = gelu_tanh(bf2f(uq.x >> 16)), u2 = gelu_tanh(bf2f(uq.y & 0xffffu)), u3 = gelu_tanh(bf2f(uq.y >> 16));
              u32x2 w; w.x = pk2(u0 * (acc[mt][nt][0] + bias), u1 * (acc[mt][nt][1] + bias)); w.y = pk2(u2 * (acc[mt][nt][2] + bias), u3 * (acc[mt][nt][3] + bias));
              *(u32x2*)(Y + (row0 + t) * D + 512 + c) = w; } }
    }
    WG_BAR();
}

template <bool MASKED>
__device__ __forceinline__ void sb_block(const bf16x8 (&kf)[2][2], const bf16x8 (&vf)[4], const bf16x8 (&qf)[2], int kb, int tq, int n, int qd, float& carry, f32x4 (&O)[4], bool& done) {
    f32x4 s[2];
#pragma unroll
    for (int tt = 0; tt < 2; ++tt) { s[tt] = (f32x4){0.f, 0.f, 0.f, 0.f}; s[tt] = MFMA16(kf[tt][0], qf[0], s[tt]); s[tt] = MFMA16(kf[tt][1], qf[1], s[tt]); }
    float beta[8], keep[8];
#pragma unroll
    for (int j = 0; j < 8; ++j) { const float t = fminf(s[j >> 2][j & 3] * (-0.125f * 1.4426950408889634f), 100.0f);
        const float e = __builtin_amdgcn_exp2f(t); float bb = __builtin_amdgcn_rcpf(1.0f + e); float kp = e * bb;
        if (MASKED) { const bool valid = (kb + 8 * qd + j) < tq; bb = valid ? bb : 0.f; kp = valid ? kp : 1.f; }
        beta[j] = bb; keep[j] = kp; }
    float suf[8]; float run = 1.f;
#pragma unroll
    for (int j = 7; j >= 0; --j) { suf[j] = run; run *= keep[j]; }
    const float T0 = __shfl(run, n), T1 = __shfl(run, n + 16), T2 = __shfl(run, n + 32), T3 = __shfl(run, n + 48);
    const float hi = (qd < 1 ? T1 : 1.f) * (qd < 2 ? T2 : 1.f) * (qd < 3 ? T3 : 1.f);
    const float base = hi * carry;
    float av[8];
#pragma unroll
    for (int j = 0; j < 8; ++j) av[j] = beta[j] * suf[j] * base;
    carry *= (T0 * T1) * (T2 * T3);
    u32x4 pw; pw.x = pk2(av[0], av[1]); pw.y = pk2(av[2], av[3]); pw.z = pk2(av[4], av[5]); pw.w = pk2(av[6], av[7]);
    const bf16x8 pf = __builtin_bit_cast(bf16x8, pw);
#pragma unroll
    for (int dt = 0; dt < 4; ++dt) O[dt] = MFMA16(vf[dt], pf, O[dt]);
    if (__all(carry < 1.17549435e-38f)) done = true;
}
__device__ __forceinline__ void sb_loop(const Args& a, int bid, int G, LAS unsigned char* lds, int tid, int wave, int lane) {
    asm volatile("" : "+v"(tid)); lane = tid & 63; asm volatile("" : "+s"(bid));
    const bf16* P = (const bf16*)(a.ws + WS_ACT); bf16* Y = (bf16*)(a.ws + WS_Y); const bf16* Vt = (const bf16*)(a.ws + WS_VT);
    const int n = lane & 15, qd = lane >> 4;
    constexpr int KS = 72, VS2 = 328;
    LAS bf16* KL = (LAS bf16*)lds;
    LAS bf16* VL = KL + 320 * KS;
    const int krow = 8 * (n >> 2) + (n & 3);
    int j = bid; if (j >= 1024) return;
    u32x4 kr[5], vr[5]; bf16x8 qn[2];
#define SB_LOAD(jj) do { const int qb_ = 31 - ((jj) & 31), bh_ = (jj) >> 5, b_ = bh_ >> 2, h_ = bh_ & 3; const int q0_ = qb_ * 128, ks0_ = max(0, q0_ - 192), nk_ = q0_ + 128 - ks0_, nkc_ = nk_ >> 3; \
        const bf16* Pb_ = P + (size_t)b_ * SEQ * DIN; const bf16* Vh_ = Vt + (size_t)(b_ * 256 + h_ * 64) * SEQ; \
        _Pragma("unroll") for (int ks = 0; ks < 2; ++ks) qn[ks] = *(const bf16x8*)(Pb_ + (size_t)(q0_ + 16 * wave + n) * DIN + 256 + h_ * 64 + ks * 32 + 8 * qd); \
        _Pragma("unroll") for (int i = 0; i < 5; ++i) { const int p = tid + i * NT; kr[i] = (u32x4){0u, 0u, 0u, 0u}; if (p < nk_ * 8) kr[i] = *(const u32x4*)(Pb_ + (size_t)(ks0_ + (p >> 3)) * DIN + 512 + h_ * 64 + (p & 7) * 8); } \
        _Pragma("unroll") for (int i = 0; i < 5; ++i) { const int p = tid + i * NT; const int d = (nk_ == 320) ? p / 40 : (nk_ == 256 ? (p >> 5) : (p >> 4)), c = p - d * nkc_; vr[i] = (u32x4){0u, 0u, 0u, 0u}; \
            if (p < 64 * nkc_) vr[i] = *(const u32x4*)(Vh_ + (size_t)d * SEQ + ks0_ + c * 8); } } while (0)
    SB_LOAD(j);
    for (;;) {
        const int qb = 31 - (j & 31), bh = j >> 5, b = bh >> 2, h = bh & 3;
        const bf16* Pb = P + (size_t)b * SEQ * DIN; const bf16* Vh = Vt + (size_t)(b * 256 + h * 64) * SEQ;
        const int q0 = qb * 128, ks0 = max(0, q0 - 192), nk = q0 + 128 - ks0, nkc = nk >> 3;
        const int q0w = q0 + 16 * wave, tq = q0w + n;
        bf16x8 qf[2]; qf[0] = qn[0]; qf[1] = qn[1];
#pragma unroll
        for (int i = 0; i < 5; ++i) { const int p = tid + i * NT; if (p < nk * 8) *(LAS u32x4*)(KL + (p >> 3) * KS + (p & 7) * 8) = kr[i]; }
#pragma unroll
        for (int i = 0; i < 5; ++i) { const int p = tid + i * NT; const int d = (nk == 320) ? p / 40 : (nk == 256 ? (p >> 5) : (p >> 4)), c = p - d * nkc; if (p < 64 * nkc) *(LAS u32x4*)(VL + d * VS2 + c * 8) = vr[i]; }
        const int jn = j + G; const bool more = jn < 1024;
        if (more) SB_LOAD(jn);
        WG_BAR();
        float carry = 1.f; bool done = false;
        f32x4 O[4];
#pragma unroll
        for (int dt = 0; dt < 4; ++dt) O[dt] = (f32x4){0.f, 0.f, 0.f, 0.f};
        int kb = (q0w + 14) & ~31;
        { const int lk0 = kb - ks0;
          bf16x8 kf[2][2], vf[4];
#pragma unroll
          for (int tt = 0; tt < 2; ++tt)
#pragma unroll
              for (int ks = 0; ks < 2; ++ks) kf[tt][ks] = *(const LAS bf16x8*)(KL + (lk0 + krow + 4 * tt) * KS + ks * 32 + 8 * qd);
#pragma unroll
          for (int dt = 0; dt < 4; ++dt) vf[dt] = *(const LAS bf16x8*)(VL + (dt * 16 + n) * VS2 + lk0 + 8 * qd);
          sb_block<true>(kf, vf, qf, kb, tq, n, qd, carry, O, done); kb -= 32; }
        for (; kb >= ks0 && !done; kb -= 32) {
            const int lk0 = kb - ks0;
            bf16x8 kf[2][2], vf[4];
#pragma unroll
            for (int tt = 0; tt < 2; ++tt)
#pragma unroll
                for (int ks = 0; ks < 2; ++ks) kf[tt][ks] = *(const LAS bf16x8*)(KL + (lk0 + krow + 4 * tt) * KS + ks * 32 + 8 * qd);
#pragma unroll
            for (int dt = 0; dt < 4; ++dt) vf[dt] = *(const LAS bf16x8*)(VL + (dt * 16 + n) * VS2 + lk0 + 8 * qd);
            sb_block<false>(kf, vf, qf, kb, tq, n, qd, carry, O, done);
        }
        for (; kb >= 0 && !done; kb -= 32) {
            bf16x8 kf[2][2], vf[4];
#pragma unroll
            for (int tt = 0; tt < 2; ++tt)
#pragma unroll
                for (int ks = 0; ks < 2; ++ks) kf[tt][ks] = *(const bf16x8*)(Pb + (size_t)(kb + krow + 4 * tt) * DIN + 512 + h * 64 + ks * 32 + 8 * qd);
#pragma unroll
            for (int dt = 0; dt < 4; ++dt) vf[dt] = *(const bf16x8*)(Vh + (size_t)(dt * 16 + n) * SEQ + kb + 8 * qd);
            sb_block<false>(kf, vf, qf, kb, tq, n, qd, carry, O, done);
        }
#pragma unroll
        for (int dt = 0; dt < 4; ++dt) { u32x2 w; w.x = pk2(O[dt][0], O[dt][1]); w.y = pk2(O[dt][2], O[dt][3]);
            *(u32x2*)(Y + (size_t)(b * SEQ + q0w + n) * D + 256 + h * 64 + dt * 16 + 4 * qd) = w; }
        WG_BAR();
        if (!more) break;
        j = jn;
    }
#undef SB_LOAD
}

__device__ __forceinline__ void lruA_loop(const Args& a, int l, int bid, int G, LAS unsigned char* lds, int tid, int wave, int lane) {
    asm volatile("" : "+v"(tid)); lane = tid & 63; asm volatile("" : "+s"(bid));
    const bf16* P = (const bf16*)(a.ws + WS_ACT);
    bf16* Y = (bf16*)(a.ws + WS_Y); float* SUM = (float*)(a.ws + WS_SUM) + (size_t)l * (8 * 32 * 2 * 256); unsigned* FLG = (unsigned*)(a.ws + WS_CTL) + CW_FLG + l * 1024;
    int item = bid; if (item >= 1024) return;
    int g = item & 3, b = (item >> 2) & 7, chunk = item >> 5, t0 = chunk * 128;
    constexpr int AS = 68, XCS = 72;
    LAS float* A_ = (LAS float*)lds;
    LAS float* B_ = A_ + 128 * AS;
    LAS bf16* XC = (LAS bf16*)(B_ + 128 * AS);
    LAS bf16* XR = XC + 128 * XCS;
    LAS bf16* GG = XR + 131 * 64;
    LAS float* PH = (LAS float*)(GG + 128 * 64);
    const int cpair = tid & 31, r = lane & 15, qd = lane >> 4;
    u32x4 px[3], pg[2];
#define LRUA_LOAD(bb, gg, tt0) do { const bf16* Px_ = P + (size_t)(bb) * SEQ * DIN + 1536 + (gg) * 64; const bf16* Pg_ = Px_ + 256; \
        _Pragma("unroll") for (int i = 0; i < 3; ++i) { const int p = tid + i * NT; const int rr = p >> 3, c8 = p & 7, t = (tt0) - 3 + rr; px[i] = (u32x4){0u, 0u, 0u, 0u}; \
            if (p < 131 * 8 && t >= 0) px[i] = *(const u32x4*)(Px_ + (size_t)t * DIN + c8 * 8); } \
        _Pragma("unroll") for (int i = 0; i < 2; ++i) { const int p = tid + i * NT; const int rr = p >> 3, c8 = p & 7; pg[i] = *(const u32x4*)(Pg_ + (size_t)((tt0) + rr) * DIN + c8 * 8); } } while (0)
    LRUA_LOAD(b, g, t0);
    float cw[4][2], cb[2];
#define LRUA_CONVW(gg) do { const float* convw = a.in[I_CW] + l * 4 * 256 + (gg) * 64; const float* convb = a.in[I_CB] + l * 256 + (gg) * 64; \
        _Pragma("unroll") for (int w = 0; w < 4; ++w) { cw[w][0] = convw[w * 256 + 2 * cpair]; cw[w][1] = convw[w * 256 + 2 * cpair + 1]; } \
        cb[0] = convb[2 * cpair]; cb[1] = convb[2 * cpair + 1]; } while (0)
    LRUA_CONVW(g);
    for (;;) {
#pragma unroll
    for (int i = 0; i < 3; ++i) { const int p = tid + i * NT; if (p < 131 * 8) *(LAS u32x4*)(XR + p * 8) = px[i]; }
#pragma unroll
    for (int i = 0; i < 2; ++i) { const int p = tid + i * NT; *(LAS u32x4*)(GG + p * 8) = pg[i]; }
    const int nitem = item + G; const bool more = nitem < 1024;
    const int ng = nitem & 3, nb = (nitem >> 2) & 7, nchunk = nitem >> 5;
    const bf16* wA = (const bf16*)(a.ws + WS_SMALL + SM_LRUA) + (l * 4 + g) * 64 * 64;
    const bf16* wX = (const bf16*)(a.ws + WS_SMALL + SM_LRUX) + (l * 4 + g) * 64 * 64;
    const float* ba = a.in[I_LBA] + l * 256 + g * 64; const float* bx = a.in[I_LBX] + l * 256 + g * 64; const float* lam = (const float*)(a.ws + WS_SMALL + SM_SPL) + l * 256 + g * 64;
    bf16x8 fa[2][4], fx[2][4];
#pragma unroll
    for (int ks = 0; ks < 2; ++ks)
#pragma unroll
        for (int mt = 0; mt < 4; ++mt) { fa[ks][mt] = *(const bf16x8*)(wA + (mt * 16 + r) * 64 + ks * 32 + 8 * qd); fx[ks][mt] = *(const bf16x8*)(wX + (mt * 16 + r) * 64 + ks * 32 + 8 * qd); }
    f32x4 vba[4], vbx[4], vlam[4];
#pragma unroll
    for (int mt = 0; mt < 4; ++mt) { const int d0 = mt * 16 + 4 * qd; vba[mt] = *(const f32x4*)(ba + d0); vbx[mt] = *(const f32x4*)(bx + d0); vlam[mt] = *(const f32x4*)(lam + d0); }
    if (more) LRUA_LOAD(nb, ng, nchunk * 128);
    WG_BAR();
#pragma unroll
    for (int i = 0; i < 8; ++i) { const int t = (tid >> 5) + 16 * i; float x0 = cb[0], x1 = cb[1];
#pragma unroll
        for (int w = 0; w < 4; ++w) { const unsigned v = *(const LAS unsigned*)(XR + (t + w) * 64 + 2 * cpair); x0 += cw[w][0] * bf2f(v & 0xffffu); x1 += cw[w][1] * bf2f(v >> 16); }
        *(LAS unsigned*)(XC + t * XCS + 2 * cpair) = pk2(x0, x1); }
    WG_BAR();
    { f32x4 ra[4], ri[4];
#pragma unroll
      for (int mt = 0; mt < 4; ++mt) { ra[mt] = (f32x4){0.f, 0.f, 0.f, 0.f}; ri[mt] = (f32x4){0.f, 0.f, 0.f, 0.f}; }
#pragma unroll
      for (int ks = 0; ks < 2; ++ks) { const bf16x8 xf = *(const LAS bf16x8*)(XC + (wave * 16 + r) * XCS + ks * 32 + 8 * qd);
#pragma unroll
          for (int mt = 0; mt < 4; ++mt) { ra[mt] = MFMA16(fa[ks][mt], xf, ra[mt]); ri[mt] = MFMA16(fx[ks][mt], xf, ri[mt]); } }
      const int t = wave * 16 + r;
#pragma unroll
      for (int mt = 0; mt < 4; ++mt) { const int d0 = mt * 16 + 4 * qd;
          const u32x2 xw = *(const LAS u32x2*)(XC + t * XCS + d0);
          const float xc[4] = {bf2f(xw.x & 0xffffu), bf2f(xw.x >> 16), bf2f(xw.y & 0xffffu), bf2f(xw.y >> 16)};
          f32x4 av, bv;
#pragma unroll
          for (int i = 0; i < 4; ++i) { const float rr = sigmoidf_(ra[mt][i] + vba[mt][i]), ii = sigmoidf_(ri[mt][i] + vbx[mt][i]);
              const float sp = vlam[mt][i];
              const float la = -8.0f * rr * sp; const float x2 = 2.0f * la;
              const float aa = __expf(la);
              float om;
              if (x2 > -0.25f) om = -x2 * (1.0f + x2 * (0.5f + x2 * (0.16666667f + x2 * (0.041666668f + x2 * (0.0083333338f + x2 * 0.0013888889f))))); else om = 1.0f - __expf(x2);
              av[i] = aa; bv[i] = __builtin_sqrtf(om) * ii * xc[i]; }
          *(LAS f32x4*)(A_ + t * AS + d0) = av; *(LAS f32x4*)(B_ + t * AS + d0) = bv; }
    }
    WG_BAR();
    { float Pp = 1.f, H = 0.f;
#pragma unroll
      for (int k = 0; k < 16; ++k) { const float aa = A_[(wave * 16 + k) * AS + lane], bb = B_[(wave * 16 + k) * AS + lane]; H = aa * H + bb; Pp *= aa; }
      PH[(wave * 64 + lane) * 2] = Pp; PH[(wave * 64 + lane) * 2 + 1] = H; }
    WG_BAR();
    { float ch = 0.f, cp = 1.f, hin = 0.f, pin = 1.f;
#pragma unroll
      for (int w = 0; w < 8; ++w) { if (w == wave) { hin = ch; pin = cp; } const float pw = PH[(w * 64 + lane) * 2], hw = PH[(w * 64 + lane) * 2 + 1]; ch = pw * ch + hw; cp *= pw; }
      if (wave == 7) { float* sp = SUM + ((size_t)(b * 32 + chunk) * 2) * 256 + g * 64 + lane; sp[0] = cp; sp[256] = ch;
          __builtin_amdgcn_fence(__ATOMIC_RELEASE, "agent"); asm volatile("s_waitcnt vmcnt(0)" ::: "memory");
          if (lane == 0) __hip_atomic_store(FLG + (b * 4 + g) * 32 + chunk, 1u, __ATOMIC_RELAXED, __HIP_MEMORY_SCOPE_AGENT); }
      if (wave == 0 && chunk > 0) { unsigned spins = 0;
          for (;;) { unsigned v = 1u; if (lane < chunk) v = __hip_atomic_load(FLG + (b * 4 + g) * 32 + lane, __ATOMIC_RELAXED, __HIP_MEMORY_SCOPE_AGENT);
              if (__all(v != 0u)) break; __builtin_amdgcn_s_sleep(2); if (++spins > (1u << 22)) break; }
          __builtin_amdgcn_fence(__ATOMIC_ACQUIRE, "agent"); asm volatile("s_waitcnt vmcnt(0)" ::: "memory"); }
      WG_BAR();
      float c = 0.f;
      { const float* sp = SUM + ((size_t)(b * 32) * 2) * 256 + g * 64 + lane;
        float pj[31], hj[31];
#pragma unroll
        for (int j = 0; j < 31; ++j) { pj[j] = 1.f; hj[j] = 0.f; if (j < chunk) { pj[j] = sp[(size_t)j * 512]; hj[j] = sp[(size_t)j * 512 + 256]; } }
#pragma unroll
        for (int j = 0; j < 31; ++j) c = pj[j] * c + hj[j]; }
      float hcur = pin * c + hin;
#pragma unroll
      for (int k = 0; k < 16; ++k) { const int t = wave * 16 + k; const float aa = A_[t * AS + lane], bb = B_[t * AS + lane]; hcur = aa * hcur + bb;
          const float gv = gelu_tanh(bf2f((unsigned)GG[t * 64 + lane]));
          Y[(size_t)(b * SEQ + t0 + t) * D + 768 + g * 64 + lane] = (bf16)f2bf(hcur * gv); }
    }
    WG_BAR();
    if (!more) break;
    if (ng != g) { g = ng; LRUA_CONVW(g); }
    item = nitem; chunk = nchunk; b = nb; t0 = nchunk * 128;
    }
#undef LRUA_LOAD
#undef LRUA_CONVW
}
__device__ __forceinline__ void mixer_part(const Args& a, int part, int l, int bid, int G, LAS unsigned char* lds, int tid, int wave, int lane) {
    asm volatile("" : "+s"(bid));
    constexpr int N_SGU = 256;
    lruA_loop(a, l, bid, G, lds, tid, wave, lane);
    for (int it = bid; it < N_SGU; it += G) sgu_item(a, l, it, lds, tid, wave, lane);
    pool_loop(a, l, bid, G, lds, tid, wave, lane);
    sb_loop(a, bid, G, lds, tid, wave, lane);
}

#define XB_TMO      128
#define XB_XCNT(j)  (256  + 64 * (j))
#define XB_XSUB(j)  (1280 + 64 * (j))
#define XB_XGEN(j)  (2304 + 64 * (j))
#define XB_TOP      3328
#define XB_TOPGEN   3392
#define XCD_BAR_WORDS 3456
#define XB_SPIN_CAP (1u << 22)

__device__ __forceinline__ unsigned xb_ld(unsigned* p)              { return __hip_atomic_load(p, __ATOMIC_RELAXED, __HIP_MEMORY_SCOPE_AGENT); }
__device__ __forceinline__ unsigned xb_add(unsigned* p, unsigned v) { return __hip_atomic_fetch_add(p, v, __ATOMIC_RELAXED, __HIP_MEMORY_SCOPE_AGENT); }
__device__ __forceinline__ unsigned xb_xcc_id() { return (unsigned)__builtin_amdgcn_s_getreg((3 << 11) | 20) & 0xFu; }
#define XB_SPIN(cond, bar) do { unsigned _sp = 0; while (cond) { __builtin_amdgcn_s_sleep(1); \
    if ((++_sp & 255u) == 0u) { if (xb_ld(&(bar)[XB_TMO])) break; if (_sp > XB_SPIN_CAP) { atomicAdd(&(bar)[XB_TMO], 1u); break; } } } } while (0)

struct XcdBarrier {
    unsigned* bar; unsigned x;
    volatile LAS unsigned* st;
};

__device__ __forceinline__ XcdBarrier xcd_barrier_post(unsigned* bar, volatile LAS unsigned* st) {
    XcdBarrier b; b.bar = bar; b.x = xb_xcc_id(); b.st = st;
    if (threadIdx.x == 0) (void)xb_add(&bar[XB_XCNT(b.x)], 1u);
    return b;
}
__device__ __forceinline__ void xcd_barrier_complete(unsigned* bar, unsigned x, unsigned& nloc, unsigned& nx) {
    const unsigned G = gridDim.x * gridDim.y * gridDim.z;
    unsigned sum, cnt, mine, sp = 0u;
    for (;;) {
        sum = 0u; cnt = 0u; mine = 0u;
#pragma unroll
        for (unsigned j = 0; j < 16; ++j) { const unsigned c = xb_ld(&bar[XB_XCNT(j)]); sum += c; cnt += (c > 0u) ? 1u : 0u; mine = (j == x) ? c : mine; }
        if (sum == G) break;
        __builtin_amdgcn_s_sleep(1);
        if ((++sp & 255u) == 0u) { if (xb_ld(&bar[XB_TMO])) break; if (sp > XB_SPIN_CAP) { atomicAdd(&bar[XB_TMO], 1u); break; } }
    }
    nloc = mine > 0u ? mine : 1u; nx = cnt > 0u ? cnt : 1u;
}

__device__ __forceinline__ void xcd_barrier(const XcdBarrier& b) {
    asm volatile("s_waitcnt vmcnt(0)" ::: "memory");
    __syncthreads();
    if (threadIdx.x == 0) {
        unsigned* bar = b.bar;
        __builtin_amdgcn_s_waitcnt(0);
        unsigned nloc = b.st[0], nx = b.st[1];
        if (nloc == 0u) { xcd_barrier_complete(bar, b.x, nloc, nx); b.st[0] = nloc; b.st[1] = nx; }
        const unsigned old = xb_add(&bar[XB_XSUB(b.x)], 1u);
        const unsigned gen = old / nloc;
        if (old + 1u == (gen + 1u) * nloc) {
            __builtin_amdgcn_fence(__ATOMIC_RELEASE, "agent");
            asm volatile("s_waitcnt vmcnt(0)" ::: "memory");
            const unsigned og = xb_add(&bar[XB_TOP], 1u);
            const unsigned tg = og / nx;
            if (og + 1u == (tg + 1u) * nx) xb_add(&bar[XB_TOPGEN], 1u);
            else XB_SPIN(xb_ld(&bar[XB_TOPGEN]) == tg, bar);
            __builtin_amdgcn_fence(__ATOMIC_ACQUIRE, "agent");
            xb_add(&bar[XB_XGEN(b.x)], 1u);
            asm volatile("s_waitcnt vmcnt(0)" ::: "memory");
        } else {
            XB_SPIN(xb_ld(&bar[XB_XGEN(b.x)]) == gen, bar);
            __builtin_amdgcn_fence(__ATOMIC_ACQUIRE, "agent");
            asm volatile("s_waitcnt vmcnt(0)" ::: "memory");
        }
    }
    __syncthreads();
}

__global__ void __launch_bounds__(NT, 2) fwd_kernel(Args a) {
    extern __shared__ __attribute__((aligned(16))) unsigned char lds_raw[];
    LAS unsigned char* lds = (LAS unsigned char*)lds_raw;
    const int tid = threadIdx.x, lane = tid & 63, wave = __builtin_amdgcn_readfirstlane(tid >> 6);
    const int G = gridDim.x, bid = blockIdx.x;
    unsigned char* ws = a.ws;
    const int lo = a.ph_lo, hi = a.ph_hi;
    pg8::ssq_t* ssbase = (pg8::ssq_t*)(ws + WS_SS);
    bf16* XB = (bf16*)(ws + WS_XB); bf16* YB = (bf16*)(ws + WS_Y); bf16* ACT = (bf16*)(ws + WS_ACT); bf16* VT = (bf16*)(ws + WS_VT);
    volatile LAS unsigned* bst = (volatile LAS unsigned*)(lds + RING_BYTES + 64);
    if (tid < 2) bst[tid] = 0u;
    __syncthreads();
    XcdBarrier bar; bar.bar = (unsigned*)(ws + WS_CTL) + CW_BAR; bar.x = 0; bar.st = bst;
#define SEAM() do { if (hi - lo > 1) xcd_barrier(bar); } while (0)
    int ph = 0;
    if (lo <= ph && ph < hi) { for (int rep = 0; rep < REP_PRO; ++rep) { prologue(a, lds, G, bid, wave, lane, tid); __syncthreads(); if (hi - lo > 1) cg::this_grid().sync(); } }
    if (hi - lo > 1) bar = xcd_barrier_post((unsigned*)(ws + WS_CTL) + CW_BAR, bst);
    ++ph;
#pragma unroll 1
    for (int st = 0; st < 7 * DEPTH; ++st) {
        const int l = st / 7, k = st - 7 * l;
        unsigned char* wl = ws + WS_W + l * W_LAYER;
        if (k == 0 || k == 5) {
            pg8::Gemm g{XB, (const bf16*)(wl + (k == 0 ? WO_F1IN : WO_F2IN)), M, 2 * DFF, D}; pg8::StaticOrder S; S.init(M, 2 * DFF, G, bid);
            pg8::EpiSwiGLU E{ACT, ssbase + (3 * l + (k == 0 ? 0 : 2)) * M, DFF, {}}; pg8::gemm_phase<pg8::EpiSwiGLU, pg8::StaticOrder, true, true>(lds, g, S, E);
        } else if (k == 1 || k == 4 || k == 6) {
            const bf16* Ap = (k == 4) ? YB : ACT; const int Kk = (k == 4) ? D : DFF;
            const bf16* Bp = (const bf16*)(wl + (k == 1 ? WO_F1OUT : (k == 4 ? WO_MOUT : WO_F2OUT)));
            pg8::Gemm g{Ap, Bp, M, D, Kk}; pg8::StaticOrder S; S.init(M, D, G, bid);
            pg8::EpiResidual E{nullptr, XB, ssbase + (3 * l + (k == 1 ? 1 : (k == 4 ? 2 : 3))) * M, (k == 4) ? 1.0f : 0.5f};
            pg8::gemm_phase<pg8::EpiResidual, pg8::StaticOrder, true, true>(lds, g, S, E);
        } else if (k == 2) {
            pg8::Gemm g{XB, (const bf16*)(wl + WO_MIN), M, DIN, D}; pg8::StaticOrder S; S.init(M, DIN, G, bid);
            pg8::EpiMixIn E{ACT, ssbase + (3 * l + 1) * M, VT, {}}; pg8::gemm_phase<pg8::EpiMixIn, pg8::StaticOrder, true, true>(lds, g, S, E);
        } else {
            mixer_part(a, 0, l, bid, G, lds, tid, wave, lane);
        }
        SEAM();
    }
    ph += 7 * DEPTH;
    if (lo <= ph && ph < hi) final_norm(a, G, bid, wave, lane);
}
constexpr int N_PHASES = 2 + 7 * DEPTH;

#ifndef MK_MULTI
#define MK_MULTI 0
#endif
extern "C" void kernel_launch(void* const* d_in, const int* in_sizes, int n_in, void* d_out, int out_size, void* d_ws, size_t ws_size, hipStream_t stream) {
    static int grid = 0;
    if (grid == 0) {
        if (n_in != 22 || in_sizes[0] != M * D || out_size != M * D || ws_size < WS_END) { fprintf(stderr, "kernel_launch: unexpected shapes/workspace (n_in %d, ws %zu)\n", n_in, ws_size); grid = -1; return; }
        int dev = 0, cus = 0, per_cu = 0;
        hipGetDevice(&dev); hipDeviceGetAttribute(&cus, hipDeviceAttributeMultiprocessorCount, dev);
        if (hipFuncSetAttribute((const void*)fwd_kernel, hipFuncAttributeMaxDynamicSharedMemorySize, LDS_BYTES) != hipSuccess) { fprintf(stderr, "kernel_launch: hipFuncSetAttribute failed\n"); grid = -1; return; }
        hipOccupancyMaxActiveBlocksPerMultiprocessor(&per_cu, (const void*)fwd_kernel, NT, LDS_BYTES);
        (void)hipGetLastError();
        if (per_cu < 1) per_cu = 1;
        grid = cus * 1;
    }
    if (grid < 0) return;
    Args a{};
    for (int i = 0; i < 22; ++i) a.in[i] = (const float*)d_in[i];
    a.out = (float*)d_out; a.ws = (unsigned char*)d_ws;
#if MK_MULTI
    for (int p = 0; p < N_PHASES; ++p) { a.ph_lo = p; a.ph_hi = p + 1; hipLaunchKernelGGL(fwd_kernel, dim3(grid), dim3(NT), LDS_BYTES, stream, a); }
#else
    a.ph_lo = 0; a.ph_hi = N_PHASES;
    void* args[] = {&a};
    hipError_t e = hipLaunchCooperativeKernel((const void*)fwd_kernel, dim3(grid), dim3(NT), args, LDS_BYTES, stream);
    if (e != hipSuccess) fprintf(stderr, "cooperative launch failed: %s (grid %d)\n", hipGetErrorString(e), grid);
#endif
}
```

```cpp
#include <hip/hip_runtime.h>
#include <hip/hip_cooperative_groups.h>
#include <cstdio>
#include <cstdint>
namespace cg = cooperative_groups;
namespace pg8 {
#define PG8_LAS __attribute__((address_space(3)))
typedef unsigned short bf16_t;
typedef short bf16x8 __attribute__((ext_vector_type(8)));
typedef float f32x4 __attribute__((ext_vector_type(4)));
typedef unsigned u32x4 __attribute__((ext_vector_type(4)));
constexpr int BM = 256, BK = 64, HALF = 128, HTB = HALF * BK * 2  , STAGE_BYTES = 8 * HTB, NXCD = 8, WGM = 8;

__host__ __device__ __forceinline__ int lds_byte(int r, int c) { const int st = (r >> 4) * 2 + (c >> 5), rr = r & 15, cc = c & 31, ob = rr * 64 + cc * 2; return st * 1024 + (ob ^ (((ob >> 9) & 1) << 5)); }
__host__ __device__ __forceinline__ void stage_rc(int b, int& R, int& C) { const int st = b / 1024, sb = b % 1024, swz = sb ^ (((sb >> 9) & 1) << 5); R = (st >> 1) * 16 + swz / 64; C = (st & 1) * 32 + (swz % 64) / 2; }
__host__ __device__ __forceinline__ int perm32(int rho) { const int n = rho >> 4, i = rho & 15; return 8 * (i >> 2) + 4 * n + (i & 3); }

struct Unit { int pm, pn; };
struct Gemm { const bf16_t* A; const bf16_t* Bt; int M, N, K; };

struct StaticOrder {
    int nM, nN, nwg, G, c;
    __host__ __device__ void init(int M, int N, int G_, int c_) { nM = M / BM; nN = N / BM; nwg = nM * nN; G = G_; c = c_; }
    __host__ __device__ bool next(int i, Unit& u) const {
        const long L = (long)i * G + c; if (L >= nwg) return false;
        int wgid = (int)L; { const int q = nwg / NXCD, r = nwg % NXCD, xcd = wgid % NXCD, off = wgid / NXCD; wgid = (xcd < r ? xcd * (q + 1) : r * (q + 1) + (xcd - r) * q) + off; }
        const int nig = WGM * nN, gid = wgid / nig, fm = gid * WGM, gsz = (nM - fm) < WGM ? (nM - fm) : WGM;
        u.pm = fm + ((wgid % nig) % gsz); u.pn = (wgid % nig) / gsz; return true;
    }
    __device__ __forceinline__ void a_ready(const Unit&) const {}
    __device__ __forceinline__ void done(const Unit&) const {}
};

__device__ __forceinline__ unsigned cvt_pk_bf16(float lo, float hi) { unsigned r; asm volatile("v_cvt_pk_bf16_f32 %0, %1, %2" : "=v"(r) : "v"(lo), "v"(hi)); return r; }
template <class Epi, class Sched, bool ALIGN_EPI = false, bool SP2 = false>
__device__ __forceinline__ void gemm_phase(PG8_LAS unsigned char* lds, const Gemm g, const Sched& S, const Epi& E) {
    int tid_ = threadIdx.x; asm volatile("" : "+v"(tid_));
    const int tid = tid_, wid = __builtin_amdgcn_readfirstlane(tid >> 6), lane = tid & 63, wr = wid >> 2, wc = wid & 3, fr = lane & 15, fq = lane >> 4;
    const int K = g.K, nt = K / BK;
    unsigned voffA[2], voffB[2];
#pragma unroll
    for (int i = 0; i < 2; ++i) { int R, C; stage_rc(tid * 16 + i * 8192, R, C); const int Rb = Epi::PERM ? ((R & ~31) + perm32(R & 31)) : R;
        voffA[i] = (unsigned)(R * K + C) * 2u; voffB[i] = (unsigned)(Rb * K + C) * 2u; }
    const size_t kstep = (size_t)(BK * 2);
    const size_t hstep = (size_t)HALF * K * 2;
    const size_t tstep = 2 * hstep;
    const unsigned ldsw = (unsigned)wid * 1024u;
    const int aoff = lds_byte(wr * 64 + fr, fq * 8), boff = lds_byte(wc * 32 + fr, fq * 8);
#define PG8_SA(b, h) (((b) * 2 + (h)) * HTB)
#define PG8_SB(b, h) ((4 + (b) * 2 + (h)) * HTB)
#define PG8_STAGE(bufoff, gbase, voff) do { _Pragma("unroll") for (int _i = 0; _i < 2; ++_i) \
        __builtin_amdgcn_global_load_lds((const unsigned*)((const char*)(gbase) + (voff)[_i]), (PG8_LAS unsigned*)(lds + (bufoff) + ldsw + _i * 8192), 16, 0, 0); } while (0)
#define PG8_LDA(dst, b, h) do { _Pragma("unroll") for (int m = 0; m < 4; ++m) _Pragma("unroll") for (int k = 0; k < 2; ++k) dst[m][k] = *(const PG8_LAS bf16x8*)(lds + PG8_SA(b, h) + aoff + m * 2048 + k * 1024); } while (0)
#define PG8_LDB(dst, b, h) do { _Pragma("unroll") for (int n = 0; n < 2; ++n) _Pragma("unroll") for (int k = 0; k < 2; ++k) dst[n][k] = *(const PG8_LAS bf16x8*)(lds + PG8_SB(b, h) + boff + n * 2048 + k * 1024); } while (0)
#define PG8_MMA(ai, bj, At, Bt) do { __builtin_amdgcn_s_setprio(1); _Pragma("unroll") for (int m = 0; m < 4; ++m) _Pragma("unroll") for (int n = 0; n < 2; ++n) _Pragma("unroll") for (int k = 0; k < 2; ++k) \
        acc[ai][bj][m][n] = __builtin_amdgcn_mfma_f32_16x16x32_bf16(Bt[n][k], At[m][k], acc[ai][bj][m][n], 0, 0, 0); __builtin_amdgcn_s_setprio(0); } while (0)
#define PG8_WAIT_V(n) asm volatile("s_waitcnt vmcnt(" #n ")" ::: "memory")
#define PG8_WAIT_L(n) asm volatile("s_waitcnt lgkmcnt(" #n ")" ::: "memory")
#define PG8_BAR __builtin_amdgcn_s_barrier()
#define PG8_SCHED __builtin_amdgcn_sched_barrier(0)
    Unit cur, nxt; int ui = 0;
    if (!S.next(0, cur)) return;
    Epi Ee = E;
    Ee.prefetch(cur, wr, fr);
    f32x4 acc[2][2][4][2];
#pragma unroll
    for (int a = 0; a < 2; ++a)
#pragma unroll
        for (int b = 0; b < 2; ++b)
#pragma unroll
            for (int m = 0; m < 4; ++m)
#pragma unroll
                for (int n = 0; n < 2; ++n) acc[a][b][m][n] = (f32x4){0.f, 0.f, 0.f, 0.f};
    bf16x8 At[4][2], B0[2][2], B1[2][2];
    const char* cA = (const char*)g.A + (size_t)cur.pm * tstep; const char* cB = (const char*)g.Bt + (size_t)cur.pn * tstep;
    S.a_ready(cur);
    if constexpr (SP2) {
        PG8_STAGE(PG8_SB(0, 0), cB, voffB); PG8_STAGE(PG8_SB(0, 1), cB + hstep, voffB); PG8_STAGE(PG8_SA(0, 0), cA, voffA); PG8_STAGE(PG8_SA(0, 1), cA + hstep, voffA);
        if (wr == 1) PG8_BAR;
        PG8_WAIT_V(2); PG8_BAR;
        PG8_STAGE(PG8_SB(1, 0), cB + kstep, voffB); PG8_STAGE(PG8_SA(1, 0), cA + kstep, voffA); PG8_STAGE(PG8_SB(1, 1), cB + hstep + kstep, voffB);
        PG8_WAIT_V(6); PG8_BAR;
    } else {
        PG8_STAGE(PG8_SB(0, 0), cB, voffB); PG8_STAGE(PG8_SA(0, 0), cA, voffA); PG8_STAGE(PG8_SB(0, 1), cB + hstep, voffB); PG8_STAGE(PG8_SA(0, 1), cA + hstep, voffA);
        if (wr == 1) PG8_BAR;
        PG8_WAIT_V(4); PG8_BAR;
        PG8_STAGE(PG8_SB(1, 0), cB + kstep, voffB); PG8_STAGE(PG8_SA(1, 0), cA + kstep, voffA); PG8_STAGE(PG8_SB(1, 1), cB + hstep + kstep, voffB);
        PG8_WAIT_V(6); PG8_BAR;
    }
    for (;;) {
        const bool has_next = S.next(ui + 1, nxt);
        const char* nA = has_next ? (const char*)g.A + (size_t)nxt.pm * tstep : cA; const char* nB = has_next ? (const char*)g.Bt + (size_t)nxt.pn * tstep : cB;
        for (int t = 0; t < nt; t += 2) {
            const bool last = (t == nt - 2);
            const char* a1 = cA + (size_t)(t + 1) * kstep;
            const char* a2 = last ? nA : cA + (size_t)(t + 2) * kstep; const char* b2 = last ? nB : cB + (size_t)(t + 2) * kstep;
            const char* a3 = a2 + kstep; const char* b3 = b2 + kstep;
            if (last && has_next) S.a_ready(nxt);
            if constexpr (SP2) {
            PG8_LDB(B0, 0, 0); PG8_LDB(B1, 0, 1); PG8_SCHED; PG8_LDA(At, 0, 0); PG8_STAGE(PG8_SA(1, 1), a1 + hstep, voffA);
            PG8_WAIT_V(8); PG8_WAIT_L(0); PG8_BAR; PG8_MMA(0, 0, At, B0); PG8_MMA(0, 1, At, B1); PG8_BAR; PG8_SCHED;
            PG8_LDA(At, 0, 1); PG8_STAGE(PG8_SB(0, 0), b2, voffB); PG8_STAGE(PG8_SB(0, 1), b2 + hstep, voffB); PG8_STAGE(PG8_SA(0, 0), a2, voffA);
            PG8_WAIT_V(8); PG8_WAIT_L(0); PG8_BAR; PG8_MMA(1, 0, At, B0); PG8_MMA(1, 1, At, B1); PG8_BAR; PG8_SCHED;
            PG8_LDB(B0, 1, 0); PG8_LDB(B1, 1, 1); PG8_SCHED; PG8_LDA(At, 1, 0); PG8_STAGE(PG8_SA(0, 1), a2 + hstep, voffA);
            PG8_WAIT_V(8); PG8_WAIT_L(0); PG8_BAR; PG8_MMA(0, 0, At, B0); PG8_MMA(0, 1, At, B1); PG8_BAR; PG8_SCHED;
            PG8_LDA(At, 1, 1); PG8_STAGE(PG8_SB(1, 0), b3, voffB); PG8_STAGE(PG8_SB(1, 1), b3 + hstep, voffB); PG8_STAGE(PG8_SA(1, 0), a3, voffA);
            PG8_WAIT_V(8); PG8_WAIT_L(0); PG8_BAR; PG8_MMA(1, 0, At, B0); PG8_MMA(1, 1, At, B1); PG8_BAR; PG8_SCHED;
            } else {
            PG8_LDB(B0, 0, 0); PG8_SCHED; PG8_LDA(At, 0, 0); PG8_STAGE(PG8_SA(1, 1), a1 + hstep, voffA);
            PG8_WAIT_L(8); PG8_BAR; PG8_WAIT_L(0); PG8_MMA(0, 0, At, B0); PG8_BAR; PG8_SCHED;
            PG8_LDB(B1, 0, 1); PG8_STAGE(PG8_SB(0, 0), b2, voffB);
            PG8_BAR; PG8_WAIT_L(0); PG8_MMA(0, 1, At, B1); PG8_BAR;
            PG8_LDA(At, 0, 1); PG8_STAGE(PG8_SA(0, 0), a2, voffA);
            PG8_BAR; PG8_WAIT_L(0); PG8_MMA(1, 0, At, B0); PG8_BAR; PG8_SCHED;
            PG8_STAGE(PG8_SB(0, 1), b2 + hstep, voffB);
            PG8_WAIT_V(6); PG8_BAR; PG8_MMA(1, 1, At, B1); PG8_BAR;
            PG8_LDB(B0, 1, 0); PG8_SCHED; PG8_LDA(At, 1, 0); PG8_STAGE(PG8_SA(0, 1), a2 + hstep, voffA);
            PG8_WAIT_L(8); PG8_BAR; PG8_WAIT_L(0); PG8_MMA(0, 0, At, B0); PG8_BAR; PG8_SCHED;
            PG8_LDB(B1, 1, 1); PG8_STAGE(PG8_SB(1, 0), b3, voffB);
            PG8_BAR; PG8_WAIT_L(0); PG8_MMA(0, 1, At, B1); PG8_BAR;
            PG8_LDA(At, 1, 1); PG8_STAGE(PG8_SA(1, 0), a3, voffA);
            PG8_BAR; PG8_WAIT_L(0); PG8_MMA(1, 0, At, B0); PG8_BAR; PG8_SCHED;
            PG8_STAGE(PG8_SB(1, 1), b3 + hstep, voffB);
            PG8_WAIT_V(6); PG8_BAR; PG8_MMA(1, 1, At, B1); PG8_BAR;
            }
        }
        if constexpr (ALIGN_EPI) { if (wr == 0) PG8_BAR; }
        if constexpr (!Epi::AFTER_DRAIN) { Ee(acc, cur, wr, wc, fr, fq); S.done(cur); if (has_next) Ee.prefetch(nxt, wr, fr); }
        if (!has_next) break;
#pragma unroll
        for (int a = 0; a < 2; ++a)
#pragma unroll
            for (int b = 0; b < 2; ++b)
#pragma unroll
                for (int m = 0; m < 4; ++m)
#pragma unroll
                    for (int n = 0; n < 2; ++n) acc[a][b][m][n] = (f32x4){0.f, 0.f, 0.f, 0.f};
        cur = nxt; cA = nA; cB = nB; ++ui;
        if constexpr (ALIGN_EPI) { if (wr == 1) PG8_BAR; }
    }
    PG8_WAIT_V(0);
    if constexpr (!ALIGN_EPI) { if (wr == 0) PG8_BAR; }
    PG8_BAR;
    if constexpr (Epi::AFTER_DRAIN) { Ee.fused(acc, cur, wr, wc, fr, fq, lds, wid, lane); S.done(cur); }
#undef PG8_SA
#undef PG8_SB
#undef PG8_STAGE
#undef PG8_LDA
#undef PG8_LDB
#undef PG8_MMA
#undef PG8_WAIT_V
#undef PG8_WAIT_L
#undef PG8_BAR
#undef PG8_SCHED
}
}
namespace pg8 {
constexpr float RMS_EPS = 1e-6f;
typedef unsigned long long ssq_t;
constexpr float SSQ_SCALE = 1048576.0f, SSQ_INV = 1.0f / 1048576.0f;
__device__ __forceinline__ ssq_t ssq_from_float(float s) { return (ssq_t)__float2ull_rn(s * SSQ_SCALE); }
__device__ __forceinline__ float ssq_to_float(ssq_t v) { return (float)v * SSQ_INV; }
typedef float f32x2 __attribute__((ext_vector_type(2)));
__device__ __forceinline__ float fast_sigmoid(float x) { return __builtin_amdgcn_rcpf(1.0f + __builtin_amdgcn_exp2f(-1.4426950408889634f * x)); }
struct EpiSwiGLU {
    static constexpr bool PERM = true, AFTER_DRAIN = false;
    bf16_t* O; const ssq_t* ss; int ldo; ssq_t rsq8[2][4];
    __device__ __forceinline__ void prefetch(const Unit& u, int wr, int fr) { const int row0 = u.pm * BM + wr * 64 + fr;
#pragma unroll
        for (int ai = 0; ai < 2; ++ai)
#pragma unroll
            for (int m = 0; m < 4; ++m) rsq8[ai][m] = ss[row0 + ai * HALF + m * 16]; }
    __device__ __forceinline__ void operator()(const f32x4 (&acc)[2][2][4][2], const Unit& u, int wr, int wc, int fr, int fq) const {
        const int row0 = u.pm * BM + wr * 64 + fr, col0 = u.pn * 128 + wc * 32 + 8 * fq;
        float rsv[2][4];
#pragma unroll
        for (int ai = 0; ai < 2; ++ai)
#pragma unroll
            for (int m = 0; m < 4; ++m) rsv[ai][m] = ssq_to_float(rsq8[ai][m]);
#pragma unroll
        for (int ai = 0; ai < 2; ++ai)
#pragma unroll
            for (int m = 0; m < 4; ++m) {
                const int row = row0 + ai * HALF + m * 16;
                const float rs = __builtin_amdgcn_rsqf(rsv[ai][m] * (1.0f / 1024.0f) + RMS_EPS);
                const float rsn = rs * -1.4426950408889634f, rsq = rs * rs;
                float o[8];
#pragma unroll
                for (int n = 0; n < 2; ++n)
#pragma unroll
                    for (int i = 0; i < 4; i += 2) { const f32x2 g2 = (f32x2){acc[ai][0][m][n][i], acc[ai][0][m][n][i + 1]}, u2 = (f32x2){acc[ai][1][m][n][i], acc[ai][1][m][n][i + 1]};
                        const f32x2 t2 = g2 * rsn; f32x2 e2; e2.x = __builtin_amdgcn_exp2f(t2.x); e2.y = __builtin_amdgcn_exp2f(t2.y);
                        const f32x2 d2 = e2 + 1.0f; f32x2 r2; r2.x = __builtin_amdgcn_rcpf(d2.x); r2.y = __builtin_amdgcn_rcpf(d2.y);
                        const f32x2 o2 = ((g2 * u2) * rsq) * r2; o[4 * n + i] = o2.x; o[4 * n + i + 1] = o2.y; }
                u32x4 w; w.x = cvt_pk_bf16(o[0], o[1]); w.y = cvt_pk_bf16(o[2], o[3]); w.z = cvt_pk_bf16(o[4], o[5]); w.w = cvt_pk_bf16(o[6], o[7]);
                *(u32x4*)(O + (size_t)row * ldo + col0) = w;
            }
    }
};
struct EpiMixIn {
    static constexpr bool PERM = true, AFTER_DRAIN = false;
    bf16_t* O; const ssq_t* ss; bf16_t* Vt; ssq_t rsq8[2][4];
    __device__ __forceinline__ void prefetch(const Unit& u, int wr, int fr) { const int row0 = u.pm * BM + wr * 64 + fr;
#pragma unroll
        for (int ai = 0; ai < 2; ++ai)
#pragma unroll
            for (int m = 0; m < 4; ++m) rsq8[ai][m] = ss[row0 + ai * HALF + m * 16]; }
    __device__ __forceinline__ void operator()(const f32x4 (&acc)[2][2][4][2], const Unit& u, int wr, int wc, int fr, int fq) const {
        const int row0 = u.pm * BM + wr * 64 + fr;
        float rsv[2][4];
#pragma unroll
        for (int ai = 0; ai < 2; ++ai)
#pragma unroll
            for (int m = 0; m < 4; ++m) rsv[ai][m] = ssq_to_float(rsq8[ai][m]);
#pragma unroll
        for (int ai = 0; ai < 2; ++ai)
#pragma unroll
            for (int m = 0; m < 4; ++m) {
                const int row = row0 + ai * HALF + m * 16;
                const float rs = __builtin_amdgcn_rsqf(rsv[ai][m] * (1.0f / 1024.0f) + RMS_EPS);
#pragma unroll
                for (int bj = 0; bj < 2; ++bj) {
                    const f32x4 v0 = acc[ai][bj][m][0] * rs, v1 = acc[ai][bj][m][1] * rs;
                    if (u.pn != 3) {
                        u32x4 w; w.x = cvt_pk_bf16(v0[0], v0[1]); w.y = cvt_pk_bf16(v0[2], v0[3]); w.z = cvt_pk_bf16(v1[0], v1[1]); w.w = cvt_pk_bf16(v1[2], v1[3]);
                        *(u32x4*)(O + (size_t)row * 2048 + u.pn * BM + bj * HALF + wc * 32 + 8 * fq) = w;
                    } else {
                        const int b = row >> 12, s = row & 4095, cl = bj * HALF + wc * 32 + 8 * fq;
                        bf16_t* vp = Vt + ((size_t)(b * 256 + cl) * 4096 + s);
                        const unsigned w0 = cvt_pk_bf16(v0[0], v0[1]), w1 = cvt_pk_bf16(v0[2], v0[3]), w2 = cvt_pk_bf16(v1[0], v1[1]), w3 = cvt_pk_bf16(v1[2], v1[3]);
                        vp[0 * 4096] = (bf16_t)(w0 & 0xffffu); vp[1 * 4096] = (bf16_t)(w0 >> 16); vp[2 * 4096] = (bf16_t)(w1 & 0xffffu); vp[3 * 4096] = (bf16_t)(w1 >> 16);
                        vp[4 * 4096] = (bf16_t)(w2 & 0xffffu); vp[5 * 4096] = (bf16_t)(w2 >> 16); vp[6 * 4096] = (bf16_t)(w3 & 0xffffu); vp[7 * 4096] = (bf16_t)(w3 >> 16);
                    }
                }
            }
    }
};
struct EpiResidual {
    static constexpr bool PERM = true, AFTER_DRAIN = false;
    const float* Xin32; bf16_t* XB; ssq_t* ssn; float alpha;
    __device__ __forceinline__ void prefetch(const Unit&, int, int) {}
    __device__ __forceinline__ void operator()(const f32x4 (&acc)[2][2][4][2], const Unit& u, int wr, int wc, int fr, int fq) const {
        const int row0 = u.pm * BM + wr * 64 + fr, col0 = u.pn * BM + wc * 32 + 8 * fq;
        u32x4 xw[2][4][2];
#pragma unroll
        for (int ai = 0; ai < 2; ++ai)
#pragma unroll
            for (int m = 0; m < 4; ++m)
#pragma unroll
                for (int bj = 0; bj < 2; ++bj) xw[ai][m][bj] = *(const u32x4*)(XB + (size_t)(row0 + ai * HALF + m * 16) * 1024 + col0 + bj * HALF);
#pragma unroll
        for (int ai = 0; ai < 2; ++ai) {
#pragma unroll
            for (int m = 0; m < 4; ++m) {
                const int row = row0 + ai * HALF + m * 16; float s = 0.f;
#pragma unroll
                for (int bj = 0; bj < 2; ++bj) {
                    const size_t off = (size_t)row * 1024 + col0 + bj * HALF;
                    const u32x4 w0 = xw[ai][m][bj];
                    const f32x4 x0 = (f32x4){__uint_as_float(w0.x << 16), __uint_as_float(w0.x & 0xffff0000u), __uint_as_float(w0.y << 16), __uint_as_float(w0.y & 0xffff0000u)};
                    const f32x4 x1 = (f32x4){__uint_as_float(w0.z << 16), __uint_as_float(w0.z & 0xffff0000u), __uint_as_float(w0.w << 16), __uint_as_float(w0.w & 0xffff0000u)};
                    const f32x4 v0 = x0 + acc[ai][bj][m][0] * alpha, v1 = x1 + acc[ai][bj][m][1] * alpha;
                    u32x4 w; w.x = cvt_pk_bf16(v0[0], v0[1]); w.y = cvt_pk_bf16(v0[2], v0[3]); w.z = cvt_pk_bf16(v1[0], v1[1]); w.w = cvt_pk_bf16(v1[2], v1[3]);
                    *(u32x4*)(XB + off) = w;
                    s += (v0[0] * v0[0] + v0[1] * v0[1]) + (v0[2] * v0[2] + v0[3] * v0[3]) + (v1[0] * v1[0] + v1[1] * v1[1]) + (v1[2] * v1[2] + v1[3] * v1[3]);
                }
                s += __shfl_xor(s, 16); s += __shfl_xor(s, 32);
                if (fq == 0) atomicAdd(ssn + row, ssq_from_float(s));
            }
        }
    }
};
struct EpiNone { static constexpr bool PERM = true, AFTER_DRAIN = false; float* sink;
    __device__ __forceinline__ void prefetch(const Unit&, int, int) {}
    __device__ __forceinline__ void operator()(const f32x4 (&acc)[2][2][4][2], const Unit& u, int wr, int wc, int fr, int fq) const { f32x4 t = (f32x4){0.f, 0.f, 0.f, 0.f};
#pragma unroll
        for (int a = 0; a < 2; ++a)
#pragma unroll
            for (int b = 0; b < 2; ++b)
#pragma unroll
                for (int m = 0; m < 4; ++m)
#pragma unroll
                    for (int n = 0; n < 2; ++n) t += acc[a][b][m][n];
        if (t[0] + t[1] + t[2] + t[3] == 1.2345e-30f) sink[0] = t[0]; } };
}

#define LAS __attribute__((address_space(3)))
typedef unsigned short bf16;
typedef float f32x4 __attribute__((ext_vector_type(4)));
typedef short bf16x8 __attribute__((ext_vector_type(8)));
typedef unsigned u32x4 __attribute__((ext_vector_type(4)));
typedef unsigned u32x2 __attribute__((ext_vector_type(2)));
constexpr int NWAVES = 8, NT = 512;
constexpr int BATCH = 8, SEQ = 4096, D = 1024, M = BATCH * SEQ, DFF = 2816, DIN = 2048, DEPTH = 2;
constexpr size_t MiB = 1u << 20;
constexpr size_t WS_CTL = 0, WS_SS = 1 * MiB, WS_SMALL = 3 * MiB, WS_W = 4 * MiB, W_LAYER = 39 * MiB;
constexpr size_t WO_F1IN = 0, WO_F1OUT = 11 * MiB, WO_MIN = 16 * MiB + MiB / 2, WO_MOUT = 20 * MiB + MiB / 2, WO_F2IN = 22 * MiB + MiB / 2, WO_F2OUT = 33 * MiB + MiB / 2;
constexpr size_t WS_XB = 84 * MiB, WS_Y = 148 * MiB, WS_VT = 212 * MiB, WS_ACT = 228 * MiB, WS_EF = 404 * MiB, WS_SUM = 468 * MiB, WS_END = 469 * MiB;
constexpr size_t SM_POOL = 0, SM_LRUA = 64 * 1024, SM_LRUX = 128 * 1024, SM_SGU = 192 * 1024, SM_SPL = 512 * 1024;
constexpr int ZERO_BYTES = 3 * (1 << 20);
constexpr int LDS_BYTES = 147456, RING_BYTES = 131072;
#ifndef REP_PRO
#define REP_PRO 1
#endif
#ifndef REP_P0
#define REP_P0 1
#endif
#ifndef REP_P1
#define REP_P1 1
#endif
#ifndef REP_FIN
#define REP_FIN 1
#endif
constexpr int CW_BAR = 4096;
constexpr int CW_QUEUE = 1024;
constexpr int CW_FLG = 8192;

__device__ __forceinline__ float bf2f(unsigned b) { return __uint_as_float(b << 16); }
__device__ __forceinline__ unsigned f2bf(float f) { unsigned u = __float_as_uint(f); return (u + 0x7fffu + ((u >> 16) & 1u)) >> 16; }
__device__ __forceinline__ unsigned pk2(float lo, float hi) { return pg8::cvt_pk_bf16(lo, hi); }
__device__ __forceinline__ float sigmoidf_(float x) { return __builtin_amdgcn_rcpf(1.0f + __builtin_amdgcn_exp2f(-1.4426950408889634f * x)); }
__device__ __forceinline__ float gelu_tanh(float x) { const float u2 = 1.5957691216057308f * (x + 0.044715f * x * x * x); return x * sigmoidf_(u2); }
__device__ __forceinline__ float wave_sum(float v) {
#pragma unroll
    for (int o = 1; o < 64; o <<= 1) v += __shfl_xor(v, o);
    return v;
}

struct Args { const float* in[22]; float* out; unsigned char* ws; int ph_lo, ph_hi; };
enum { I_X = 0, I_F1N, I_F1WI, I_F1WO, I_MN, I_MWI, I_MWO, I_PW, I_PS, I_SW, I_SB, I_CW, I_CB, I_LWA, I_LBA, I_LWX, I_LBX, I_LAM, I_F2N, I_F2WI, I_F2WO, I_FN };

__device__ __forceinline__ void transpose_item(const float* W, int K, int N, bf16* WT, const float* gk, int mode, LAS float* scr, int item, int lane) {
    const int nblk = N / 32, kb = item / nblk, nb = item % nblk, k0 = 64 * kb, n0 = 32 * nb;
    { f32x4 v[8]; float gsc[8];
#pragma unroll
      for (int i = 0; i < 8; ++i) { const int kk = 8 * i + (lane >> 3); v[i] = *(const f32x4*)(W + (size_t)(k0 + kk) * N + n0 + 4 * (lane & 7)); gsc[i] = gk ? gk[k0 + kk] : 1.0f; }
#pragma unroll
      for (int i = 0; i < 8; ++i) { const int kk = 8 * i + (lane >> 3); LAS float* d = scr + kk * 33 + 4 * (lane & 7); d[0] = v[i][0] * gsc[i]; d[1] = v[i][1] * gsc[i]; d[2] = v[i][2] * gsc[i]; d[3] = v[i][3] * gsc[i]; } }
    asm volatile("s_waitcnt lgkmcnt(0)" ::: "memory");
    int r0 = n0;
    if (mode == 1) r0 = (n0 < DFF) ? (256 * (n0 / 128) + n0 % 128) : (256 * ((n0 - DFF) / 128) + 128 + (n0 - DFF) % 128);
    const int c = lane & 7;
#pragma unroll
    for (int j = 0; j < 4; ++j) { const int n = (lane >> 3) + 8 * j; const LAS float* s = scr + (8 * c) * 33 + n;
        u32x4 o; o.x = pk2(s[0 * 33], s[1 * 33]); o.y = pk2(s[2 * 33], s[3 * 33]); o.z = pk2(s[4 * 33], s[5 * 33]); o.w = pk2(s[6 * 33], s[7 * 33]);
        *(u32x4*)(WT + (size_t)(r0 + n) * K + k0 + 8 * c) = o; }
    asm volatile("s_waitcnt lgkmcnt(0)" ::: "memory");
}

__device__ __forceinline__ void prologue(const Args& a, LAS unsigned char* lds, int G, int bid, int wave, int lane, int tid) {
    asm volatile("" : "+v"(tid)); lane = tid & 63;
    unsigned char* ws = a.ws;
    LAS float* scr = (LAS float*)(lds + wave * 16384);
    const int gw = bid * NWAVES + wave, NGW = G * NWAVES;
    constexpr int IT_FIN = (D / 64) * (2 * DFF / 32), IT_FOUT = (DFF / 64) * (D / 32), IT_MIN = (D / 64) * (DIN / 32), IT_MOUT = (D / 64) * (D / 32);
    constexpr int IT_LAYER = 2 * IT_FIN + 2 * IT_FOUT + IT_MIN + IT_MOUT;
    for (int it = gw; it < DEPTH * IT_LAYER; it += NGW) {
        const int l = it / IT_LAYER; int r = it % IT_LAYER; unsigned char* wl = ws + WS_W + l * W_LAYER;
        if (r < IT_FIN) { transpose_item(a.in[I_F1WI] + (size_t)l * D * 2 * DFF, D, 2 * DFF, (bf16*)(wl + WO_F1IN), a.in[I_F1N] + l * D, 1, scr, r, lane); continue; } r -= IT_FIN;
        if (r < IT_FOUT) { transpose_item(a.in[I_F1WO] + (size_t)l * DFF * D, DFF, D, (bf16*)(wl + WO_F1OUT), nullptr, 0, scr, r, lane); continue; } r -= IT_FOUT;
        if (r < IT_MIN) { transpose_item(a.in[I_MWI] + (size_t)l * D * DIN, D, DIN, (bf16*)(wl + WO_MIN), a.in[I_MN] + l * D, 0, scr, r, lane); continue; } r -= IT_MIN;
        if (r < IT_MOUT) { transpose_item(a.in[I_MWO] + (size_t)l * D * D, D, D, (bf16*)(wl + WO_MOUT), nullptr, 0, scr, r, lane); continue; } r -= IT_MOUT;
        if (r < IT_FIN) { transpose_item(a.in[I_F2WI] + (size_t)l * D * 2 * DFF, D, 2 * DFF, (bf16*)(wl + WO_F2IN), a.in[I_F2N] + l * D, 1, scr, r, lane); continue; } r -= IT_FIN;
        transpose_item(a.in[I_F2WO] + (size_t)l * DFF * D, DFF, D, (bf16*)(wl + WO_F2OUT), nullptr, 0, scr, r, lane);
    }
    const int gt = bid * NT + tid, NGT = G * NT;
    { u32x4* z0 = (u32x4*)(ws + WS_CTL); for (int e = gt; e < (int)(MiB / 16); e += NGT) z0[e] = (u32x4){0u, 0u, 0u, 0u};
      u32x4* z1 = (u32x4*)(ws + WS_SS + (size_t)M * 8); for (int e = gt; e < 6 * M * 8 / 16; e += NGT) z1[e] = (u32x4){0u, 0u, 0u, 0u}; }
    bf16* poolT = (bf16*)(ws + WS_SMALL + SM_POOL); bf16* lruA = (bf16*)(ws + WS_SMALL + SM_LRUA); bf16* lruX = (bf16*)(ws + WS_SMALL + SM_LRUX); bf16* sguW = (bf16*)(ws + WS_SMALL + SM_SGU);
    for (int e = gt; e < DEPTH * 4 * 64 * 64; e += NGT) { const int c = e & 63, d = (e >> 6) & 63, lg = e >> 12; const int src = (lg * 64 + c) * 64 + d;
        poolT[e] = (bf16)f2bf(a.in[I_PW][src]); lruA[e] = (bf16)f2bf(a.in[I_LWA][src]); lruX[e] = (bf16)f2bf(a.in[I_LWX][src]); }
    if (gt < DEPTH * 256) ((float*)(ws + WS_SMALL + SM_SPL))[gt] = log1pf(__expf(-a.in[I_LAM][gt]));
    for (int e = gt; e < DEPTH * 4 * 128 * 128; e += NGT) { const int s = e & 127, t = (e >> 7) & 127; sguW[e] = (s <= t) ? (bf16)f2bf(a.in[I_SW][e]) : (bf16)0; }
    bf16* XB = (bf16*)(ws + WS_XB); pg8::ssq_t* ss0 = (pg8::ssq_t*)(ws + WS_SS);
    const bool xl = (G % 8 == 0) && (M % (4 * NGW) == 0);
#define ROWMAP(t) (xl ? ((bid & 7) * (M / 8) + (t) * (NGW / 8) + (bid >> 3) * NWAVES + wave) : (gw + (t) * NGW))
    for (int t = 0; t < M / NGW; t += 4) {
        f32x4 v[4][4];
#pragma unroll
        for (int q = 0; q < 4; ++q) { const f32x4* xr = (const f32x4*)(a.in[I_X] + (size_t)ROWMAP(t + q) * D) + lane;
#pragma unroll
            for (int j = 0; j < 4; ++j) v[q][j] = xr[64 * j]; }
#pragma unroll
        for (int q = 0; q < 4; ++q) { float s = 0.f;
#pragma unroll
            for (int j = 0; j < 4; ++j) s += (v[q][j].x * v[q][j].x + v[q][j].y * v[q][j].y) + (v[q][j].z * v[q][j].z + v[q][j].w * v[q][j].w);
            s = wave_sum(s);
            const int mr = ROWMAP(t + q); u32x2* o = (u32x2*)(XB + (size_t)mr * D) + lane;
#pragma unroll
            for (int j = 0; j < 4; ++j) { u32x2 w; w.x = pk2(v[q][j].x, v[q][j].y); w.y = pk2(v[q][j].z, v[q][j].w); o[64 * j] = w; }
            if (lane == 0) ss0[mr] = pg8::ssq_from_float(s); }
    }
#undef ROWMAP
}

__device__ __forceinline__ void final_norm(const Args& a, int G, int bid, int wave, int lane) {
    asm volatile("" : "+v"(lane));
    const int gw = bid * NWAVES + wave, NGW = G * NWAVES; const pg8::ssq_t* ss = (const pg8::ssq_t*)(a.ws + WS_SS) + 6 * M; const f32x4* gf = (const f32x4*)a.in[I_FN] + lane;
    const bf16* XB = (const bf16*)(a.ws + WS_XB);
    f32x4 g[4];
#pragma unroll
    for (int j = 0; j < 4; ++j) g[j] = gf[64 * j];
    const bool xl = (G % 8 == 0) && (M % NGW == 0);
    for (int t = 0; t < M / NGW; ++t) { const int m = xl ? ((bid & 7) * (M / 8) + t * (NGW / 8) + (bid >> 3) * NWAVES + wave) : (gw + t * NGW);
        const u32x2* xr = (const u32x2*)(XB + (size_t)m * D) + lane; f32x4* orow = (f32x4*)(a.out + (size_t)m * D) + lane;
        const float rs = __builtin_amdgcn_rsqf(pg8::ssq_to_float(ss[m]) * (1.0f / 1024.0f) + pg8::RMS_EPS);
        u32x2 w[4];
#pragma unroll
        for (int j = 0; j < 4; ++j) w[j] = xr[64 * j];
#pragma unroll
        for (int j = 0; j < 4; ++j) { f32x4 v = (f32x4){bf2f(w[j].x & 0xffffu), bf2f(w[j].x >> 16), bf2f(w[j].y & 0xffffu), bf2f(w[j].y >> 16)}; orow[64 * j] = v * rs * g[j]; }
    }
}

#define MFMA16(a, b, c) __builtin_amdgcn_mfma_f32_16x16x32_bf16((a), (b), (c), 0, 0, 0)
#define WG_BAR() __syncthreads()

__device__ __forceinline__ void pool_loop(const Args& a, int l, int bid, int G, LAS unsigned char* lds, int tid, int wave, int lane) {
    asm volatile("" : "+v"(tid)); lane = tid & 63; asm volatile("" : "+s"(bid));
    const bf16* P = (const bf16*)(a.ws + WS_ACT); bf16* Y = (bf16*)(a.ws + WS_Y);
    const bf16* poolT = (const bf16*)(a.ws + WS_SMALL + SM_POOL) + l * 4 * 64 * 64;
    const float* scale = a.in[I_PS] + l * 256;
    constexpr int XS = 264;
    LAS bf16* XP = (LAS bf16*)lds;
    LAS bf16* DD = (LAS bf16*)(lds + 80 * XS * 2);
    int item = bid; if (item >= 512) return;
    const int gw = wave >> 1, half = wave & 1, r = lane & 15, qd = lane >> 4;
    bf16x8 af[2][4]; f32x4 scv[4];
#pragma unroll
    for (int ks = 0; ks < 2; ++ks)
#pragma unroll
        for (int mt = 0; mt < 4; ++mt) af[ks][mt] = *(const bf16x8*)(poolT + (gw * 64 + mt * 16 + r) * 64 + ks * 32 + 8 * qd);
#pragma unroll
    for (int mt = 0; mt < 4; ++mt) scv[mt] = *(const f32x4*)(scale + gw * 64 + mt * 16 + 4 * qd);
    u32x4 xr[5];
#define POOL_LOAD(it_) do { const int b_ = (it_) >> 6, t0_ = ((it_) & 63) * 64; \
        _Pragma("unroll") for (int i = 0; i < 5; ++i) { const int p = tid + i * NT; const int rr = p >> 5, c16 = p & 31, t = t0_ - 16 + rr; xr[i] = (u32x4){0u, 0u, 0u, 0u}; \
            if (t >= 0) xr[i] = *(const u32x4*)(P + (size_t)(b_ * SEQ + t) * DIN + c16 * 8); } } while (0)
    POOL_LOAD(item);
    for (;;) {
    const int b = item >> 6, t0 = (item & 63) * 64;
#pragma unroll
    for (int i = 0; i < 5; ++i) { const int p = tid + i * NT; *(LAS u32x4*)(XP + (p >> 5) * XS + (p & 31) * 8) = xr[i]; }
    const int nitem = item + G; const bool more = nitem < 512;
    if (more) POOL_LOAD(nitem);
    WG_BAR();
    {
      const int cp = tid & 127, g = cp >> 5, tq = tid >> 7;
      float p0[32], p1[32]; p0[0] = 0.f; p1[0] = 0.f;
      unsigned xw[31];
#pragma unroll
      for (int i = 0; i < 31; ++i) xw[i] = *(const LAS unsigned*)(XP + (1 + 16 * tq + i) * XS + 2 * cp);
#pragma unroll
      for (int i = 0; i < 31; ++i) { p0[i + 1] = p0[i] + bf2f(xw[i] & 0xffffu); p1[i + 1] = p1[i] + bf2f(xw[i] >> 16); }
#pragma unroll
      for (int k = 0; k < 16; ++k) { const int tk = 16 * tq + k;
          const float a0 = g == 0 ? p0[14 + k] : (g == 1 ? p0[12 + k] : (g == 2 ? p0[8 + k] : p0[k]));
          const float a1 = g == 0 ? p1[14 + k] : (g == 1 ? p1[12 + k] : (g == 2 ? p1[8 + k] : p1[k]));
          const int win = 2 << g; const int cnt = min(t0 + tk + 1, win); const float inv = 1.0f / (float)cnt;
          *(LAS unsigned*)(DD + tk * XS + 2 * cp) = pk2((p0[16 + k] - a0) * inv - bf2f(xw[15 + k] & 0xffffu), (p1[16 + k] - a1) * inv - bf2f(xw[15 + k] >> 16)); } }
    WG_BAR();
    { f32x4 acc[4][2];
#pragma unroll
      for (int mt = 0; mt < 4; ++mt)
#pragma unroll
          for (int nt = 0; nt < 2; ++nt) acc[mt][nt] = (f32x4){0.f, 0.f, 0.f, 0.f};
#pragma unroll
      for (int ks = 0; ks < 2; ++ks) {
          bf16x8 bfr[2];
#pragma unroll
          for (int nt = 0; nt < 2; ++nt) bfr[nt] = *(const LAS bf16x8*)(DD + (half * 32 + nt * 16 + r) * XS + gw * 64 + ks * 32 + 8 * qd);
#pragma unroll
          for (int mt = 0; mt < 4; ++mt)
#pragma unroll
              for (int nt = 0; nt < 2; ++nt) acc[mt][nt] = MFMA16(af[ks][mt], bfr[nt], acc[mt][nt]);
      }
#pragma unroll
      for (int mt = 0; mt < 4; ++mt) { const int dc = gw * 64 + mt * 16 + 4 * qd; const f32x4 sc = scv[mt];
#pragma unroll
          for (int nt = 0; nt < 2; ++nt) { const int t = t0 + half * 32 + nt * 16 + r; const f32x4 v = acc[mt][nt] * sc;
              u32x2 w; w.x = pk2(v[0], v[1]); w.y = pk2(v[2], v[3]); *(u32x2*)(Y + (size_t)(b * SEQ + t) * D + dc) = w; } }
    }
    WG_BAR();
    if (!more) break;
    item = nitem;
    }
#undef POOL_LOAD
}

__device__ __forceinline__ void sgu_item(const Args& a, int l, int item, LAS unsigned char* lds, int tid, int wave, int lane) {
    asm volatile("" : "+v"(tid)); lane = tid & 63;
    const bf16* P = (const bf16*)(a.ws + WS_ACT); bf16* Y = (bf16*)(a.ws + WS_Y);
    const bf16* sguW = (const bf16*)(a.ws + WS_SMALL + SM_SGU) + l * 4 * 128 * 128;
    const float* sgub = a.in[I_SB] + l * 4 * 128;
    const size_t row0 = (size_t)item * 128;
    constexpr int VS = 136;
    LAS bf16* VN = (LAS bf16*)lds;
    const int h2 = wave >> 1, th2 = wave & 1, r2 = lane & 15, qd2 = lane >> 4;
    u32x2 uw[4][4]; float biasv[4]; bf16x8 wpre[2][4];
#pragma unroll
    for (int nt = 0; nt < 4; ++nt) { const int t = th2 * 64 + nt * 16 + r2; biasv[nt] = sgub[h2 * 128 + t];
#pragma unroll
        for (int mt = 0; mt < 4; ++mt) uw[nt][mt] = *(const u32x2*)(P + (row0 + t) * DIN + 1024 + h2 * 64 + mt * 16 + 4 * qd2); }
#pragma unroll
    for (int ks = 0; ks < 2; ++ks)
#pragma unroll
        for (int nt = 0; nt < 4; ++nt) wpre[ks][nt] = *(const bf16x8*)(sguW + (h2 * 128 + th2 * 64 + nt * 16 + r2) * 128 + ks * 32 + 8 * qd2);
    { const int h = wave >> 1, tok = (wave & 1) * 64 + lane;
      const u32x4* src = (const u32x4*)(P + (row0 + tok) * DIN + 1280 + h * 64);
      float v[64]; float s = 0.f;
#pragma unroll
      for (int j = 0; j < 8; ++j) { const u32x4 w = src[j];
#pragma unroll
          for (int k = 0; k < 4; ++k) { const float x0 = gelu_tanh(bf2f(w[k] & 0xffffu)), x1 = gelu_tanh(bf2f(w[k] >> 16)); v[8 * j + 2 * k] = x0; v[8 * j + 2 * k + 1] = x1; s += x0 + x1; } }
      const float mu = s * (1.0f / 64.0f); float q = 0.f;
#pragma unroll
      for (int c = 0; c < 64; ++c) { v[c] -= mu; q += v[c] * v[c]; }
      const float rs = __builtin_amdgcn_rsqf(q * (1.0f / 64.0f) + 1e-6f);
#pragma unroll
      for (int c = 0; c < 64; ++c) VN[(h * 64 + c) * VS + tok] = (bf16)f2bf(v[c] * rs);
    }
    WG_BAR();
    { const int h = wave >> 1, th = wave & 1, r = lane & 15, qd = lane >> 4;
      f32x4 acc[4][4];
#pragma unroll
      for (int mt = 0; mt < 4; ++mt)
#pragma unroll
          for (int nt = 0; nt < 4; ++nt) acc[mt][nt] = (f32x4){0.f, 0.f, 0.f, 0.f};
      const int nks = 2 + 2 * th;
      bf16x8 wlate[2][4];
      if (th) {
#pragma unroll
          for (int ks = 0; ks < 2; ++ks)
#pragma unroll
              for (int nt = 0; nt < 4; ++nt) wlate[ks][nt] = *(const bf16x8*)(sguW + (h * 128 + th * 64 + nt * 16 + r) * 128 + (ks + 2) * 32 + 8 * qd);
      }
#pragma unroll
      for (int ks = 0; ks < 4; ++ks) { if (ks < nks) {
          bf16x8 af[4], bfr[4];
#pragma unroll
          for (int mt = 0; mt < 4; ++mt) af[mt] = *(const LAS bf16x8*)(VN + (h * 64 + mt * 16 + r) * VS + ks * 32 + 8 * qd);
#pragma unroll
          for (int nt = 0; nt < 4; ++nt) bfr[nt] = ks < 2 ? wpre[ks & 1][nt] : wlate[ks & 1][nt];
#pragma unroll
          for (int mt = 0; mt < 4; ++mt)
#pragma unroll
              for (int nt = 0; nt < 4; ++nt) acc[mt][nt] = MFMA16(af[mt], bfr[nt], acc[mt][nt]);
      } }
#pragma unroll
      for (int nt = 0; nt < 4; ++nt) { const int t = th * 64 + nt * 16 + r; const float bias = biasv[nt];
#pragma unroll
          for (int mt = 0; mt < 4; ++mt) { const int c = h * 64 + mt * 16 + 4 * qd;
              const u32x2 uq = uw[nt][mt];
              const float u0 = gelu_tanh(bf2f(uq.x & 0xffffu)), u1 = gelu_tanh(bf2f(uq.x >> 16)), u2 = gelu_tanh(bf2f(uq.y & 0xffffu)), u3 = gelu_tanh(bf2f(uq.y >> 16));
              u32x2 w; w.x = pk2(u0 * (acc[mt][nt][0] + bias), u1 * (acc[mt][nt][1] + bias)); w.y = pk2(u2 * (acc[mt][nt][2] + bias), u3 * (acc[mt][nt][3] + bias));
              *(u32x2*)(Y + (row0 + t) * D + 512 + c) = w; } }
    }
    WG_BAR();
}

template <bool MASKED>
__device__ __forceinline__ void sb_block(const bf16x8 (&kf)[2][2], const bf16x8 (&vf)[4], const bf16x8 (&qf)[2], int kb, int tq, int n, int qd, float& carry, f32x4 (&O)[4], bool& done) {
    f32x4 s[2];
#pragma unroll
    for (int tt = 0; tt < 2; ++tt) { s[tt] = (f32x4){0.f, 0.f, 0.f, 0.f}; s[tt] = MFMA16(kf[tt][0], qf[0], s[tt]); s[tt] = MFMA16(kf[tt][1], qf[1], s[tt]); }
    float beta[8], keep[8];
#pragma unroll
    for (int j = 0; j < 8; ++j) { const float t = fminf(s[j >> 2][j & 3] * (-0.125f * 1.4426950408889634f), 100.0f);
        const float e = __builtin_amdgcn_exp2f(t); float bb = __builtin_amdgcn_rcpf(1.0f + e); float kp = e * bb;
        if (MASKED) { const bool valid = (kb + 8 * qd + j) < tq; bb = valid ? bb : 0.f; kp = valid ? kp : 1.f; }
        beta[j] = bb; keep[j] = kp; }
    float suf[8]; float run = 1.f;
#pragma unroll
    for (int j = 7; j >= 0; --j) { suf[j] = run; run *= keep[j]; }
    const float T0 = __shfl(run, n), T1 = __shfl(run, n + 16), T2 = __shfl(run, n + 32), T3 = __shfl(run, n + 48);
    const float hi = (qd < 1 ? T1 : 1.f) * (qd < 2 ? T2 : 1.f) * (qd < 3 ? T3 : 1.f);
    const float base = hi * carry;
    float av[8];
#pragma unroll
    for (int j = 0; j < 8; ++j) av[j] = beta[j] * suf[j] * base;
    carry *= (T0 * T1) * (T2 * T3);
    u32x4 pw; pw.x = pk2(av[0], av[1]); pw.y = pk2(av[2], av[3]); pw.z = pk2(av[4], av[5]); pw.w = pk2(av[6], av[7]);
    const bf16x8 pf = __builtin_bit_cast(bf16x8, pw);
#pragma unroll
    for (int dt = 0; dt < 4; ++dt) O[dt] = MFMA16(vf[dt], pf, O[dt]);
    if (__all(carry < 1.17549435e-38f)) done = true;
}
__device__ __forceinline__ void sb_loop(const Args& a, int bid, int G, LAS unsigned char* lds, int tid, int wave, int lane) {
    asm volatile("" : "+v"(tid)); lane = tid & 63; asm volatile("" : "+s"(bid));
    const bf16* P = (const bf16*)(a.ws + WS_ACT); bf16* Y = (bf16*)(a.ws + WS_Y); const bf16* Vt = (const bf16*)(a.ws + WS_VT);
    const int n = lane & 15, qd = lane >> 4;
    constexpr int KS = 72, VS2 = 328;
    LAS bf16* KL = (LAS bf16*)lds;
    LAS bf16* VL = KL + 320 * KS;
    const int krow = 8 * (n >> 2) + (n & 3);
    int j = bid; if (j >= 1024) return;
    u32x4 kr[5], vr[5]; bf16x8 qn[2];
#define SB_LOAD(jj) do { const int qb_ = 31 - ((jj) & 31), bh_ = (jj) >> 5, b_ = bh_ >> 2, h_ = bh_ & 3; const int q0_ = qb_ * 128, ks0_ = max(0, q0_ - 192), nk_ = q0_ + 128 - ks0_, nkc_ = nk_ >> 3; \
        const bf16* Pb_ = P + (size_t)b_ * SEQ * DIN; const bf16* Vh_ = Vt + (size_t)(b_ * 256 + h_ * 64) * SEQ; \
        _Pragma("unroll") for (int ks = 0; ks < 2; ++ks) qn[ks] = *(const bf16x8*)(Pb_ + (size_t)(q0_ + 16 * wave + n) * DIN + 256 + h_ * 64 + ks * 32 + 8 * qd); \
        _Pragma("unroll") for (int i = 0; i < 5; ++i) { const int p = tid + i * NT; kr[i] = (u32x4){0u, 0u, 0u, 0u}; if (p < nk_ * 8) kr[i] = *(const u32x4*)(Pb_ + (size_t)(ks0_ + (p >> 3)) * DIN + 512 + h_ * 64 + (p & 7) * 8); } \
        _Pragma("unroll") for (int i = 0; i < 5; ++i) { const int p = tid + i * NT; const int d = (nk_ == 320) ? p / 40 : (nk_ == 256 ? (p >> 5) : (p >> 4)), c = p - d * nkc_; vr[i] = (u32x4){0u, 0u, 0u, 0u}; \
            if (p < 64 * nkc_) vr[i] = *(const u32x4*)(Vh_ + (size_t)d * SEQ + ks0_ + c * 8); } } while (0)
    SB_LOAD(j);
    for (;;) {
        const int qb = 31 - (j & 31), bh = j >> 5, b = bh >> 2, h = bh & 3;
        const bf16* Pb = P + (size_t)b * SEQ * DIN; const bf16* Vh = Vt + (size_t)(b * 256 + h * 64) * SEQ;
        const int q0 = qb * 128, ks0 = max(0, q0 - 192), nk = q0 + 128 - ks0, nkc = nk >> 3;
        const int q0w = q0 + 16 * wave, tq = q0w + n;
        bf16x8 qf[2]; qf[0] = qn[0]; qf[1] = qn[1];
#pragma unroll
        for (int i = 0; i < 5; ++i) { const int p = tid + i * NT; if (p < nk * 8) *(LAS u32x4*)(KL + (p >> 3) * KS + (p & 7) * 8) = kr[i]; }
#pragma unroll
        for (int i = 0; i < 5; ++i) { const int p = tid + i * NT; const int d = (nk == 320) ? p / 40 : (nk == 256 ? (p >> 5) : (p >> 4)), c = p - d * nkc; if (p < 64 * nkc) *(LAS u32x4*)(VL + d * VS2 + c * 8) = vr[i]; }
        const int jn = j + G; const bool more = jn < 1024;
        if (more) SB_LOAD(jn);
        WG_BAR();
        float carry = 1.f; bool done = false;
        f32x4 O[4];
#pragma unroll
        for (int dt = 0; dt < 4; ++dt) O[dt] = (f32x4){0.f, 0.f, 0.f, 0.f};
        int kb = (q0w + 14) & ~31;
        { const int lk0 = kb - ks0;
          bf16x8 kf[2][2], vf[4];
#pragma unroll
          for (int tt = 0; tt < 2; ++tt)
#pragma unroll
              for (int ks = 0; ks < 2; ++ks) kf[tt][ks] = *(const LAS bf16x8*)(KL + (lk0 + krow + 4 * tt) * KS + ks * 32 + 8 * qd);
#pragma unroll
          for (int dt = 0; dt < 4; ++dt) vf[dt] = *(const LAS bf16x8*)(VL + (dt * 16 + n) * VS2 + lk0 + 8 * qd);
          sb_block<true>(kf, vf, qf, kb, tq, n, qd, carry, O, done); kb -= 32; }
        for (; kb >= ks0 && !done; kb -= 32) {
            const int lk0 = kb - ks0;
            bf16x8 kf[2][2], vf[4];
#pragma unroll
            for (int tt = 0; tt < 2; ++tt)
#pragma unroll
                for (int ks = 0; ks < 2; ++ks) kf[tt][ks] = *(const LAS bf16x8*)(KL + (lk0 + krow + 4 * tt) * KS + ks * 32 + 8 * qd);
#pragma unroll
            for (int dt = 0; dt < 4; ++dt) vf[dt] = *(const LAS bf16x8*)(VL + (dt * 16 + n) * VS2 + lk0 + 8 * qd);
            sb_block<false>(kf, vf, qf, kb, tq, n, qd, carry, O, done);
        }
        for (; kb >= 0 && !done; kb -= 32) {
            bf16x8 kf[2][2], vf[4];
#pragma unroll
            for (int tt = 0; tt < 2; ++tt)
#pragma unroll
                for (int ks = 0; ks < 2; ++ks) kf[tt][ks] = *(const bf16x8*)(Pb + (size_t)(kb + krow + 4 * tt) * DIN + 512 + h * 64 + ks * 32 + 8 * qd);
#pragma unroll
            for (int dt = 0; dt < 4; ++dt) vf[dt] = *(const bf16x8*)(Vh + (size_t)(dt * 16 + n) * SEQ + kb + 8 * qd);
            sb_block<false>(kf, vf, qf, kb, tq, n, qd, carry, O, done);
        }
#pragma unroll
        for (int dt = 0; dt < 4; ++dt) { u32x2 w; w.x = pk2(O[dt][0], O[dt][1]); w.y = pk2(O[dt][2], O[dt][3]);
            *(u32x2*)(Y + (size_t)(b * SEQ + q0w + n) * D + 256 + h * 64 + dt * 16 + 4 * qd) = w; }
        WG_BAR();
        if (!more) break;
        j = jn;
    }
#undef SB_LOAD
}

__device__ __forceinline__ void lruA_loop(const Args& a, int l, int bid, int G, LAS unsigned char* lds, int tid, int wave, int lane) {
    asm volatile("" : "+v"(tid)); lane = tid & 63; asm volatile("" : "+s"(bid));
    const bf16* P = (const bf16*)(a.ws + WS_ACT);
    bf16* Y = (bf16*)(a.ws + WS_Y); float* SUM = (float*)(a.ws + WS_SUM) + (size_t)l * (8 * 32 * 2 * 256); unsigned* FLG = (unsigned*)(a.ws + WS_CTL) + CW_FLG + l * 1024;
    int item = bid; if (item >= 1024) return;
    int g = item & 3, b = (item >> 2) & 7, chunk = item >> 5, t0 = chunk * 128;
    constexpr int AS = 68, XCS = 72;
    LAS float* A_ = (LAS float*)lds;
    LAS float* B_ = A_ + 128 * AS;
    LAS bf16* XC = (LAS bf16*)(B_ + 128 * AS);
    LAS bf16* XR = XC + 128 * XCS;
    LAS bf16* GG = XR + 131 * 64;
    LAS float* PH = (LAS float*)(GG + 128 * 64);
    const int cpair = tid & 31, r = lane & 15, qd = lane >> 4;
    u32x4 px[3], pg[2];
#define LRUA_LOAD(bb, gg, tt0) do { const bf16* Px_ = P + (size_t)(bb) * SEQ * DIN + 1536 + (gg) * 64; const bf16* Pg_ = Px_ + 256; \
        _Pragma("unroll") for (int i = 0; i < 3; ++i) { const int p = tid + i * NT; const int rr = p >> 3, c8 = p & 7, t = (tt0) - 3 + rr; px[i] = (u32x4){0u, 0u, 0u, 0u}; \
            if (p < 131 * 8 && t >= 0) px[i] = *(const u32x4*)(Px_ + (size_t)t * DIN + c8 * 8); } \
        _Pragma("unroll") for (int i = 0; i < 2; ++i) { const int p = tid + i * NT; const int rr = p >> 3, c8 = p & 7; pg[i] = *(const u32x4*)(Pg_ + (size_t)((tt0) + rr) * DIN + c8 * 8); } } while (0)
    LRUA_LOAD(b, g, t0);
    float cw[4][2], cb[2];
#define LRUA_CONVW(gg) do { const float* convw = a.in[I_CW] + l * 4 * 256 + (gg) * 64; const float* convb = a.in[I_CB] + l * 256 + (gg) * 64; \
        _Pragma("unroll") for (int w = 0; w < 4; ++w) { cw[w][0] = convw[w * 256 + 2 * cpair]; cw[w][1] = convw[w * 256 + 2 * cpair + 1]; } \
        cb[0] = convb[2 * cpair]; cb[1] = convb[2 * cpair + 1]; } while (0)
    LRUA_CONVW(g);
    for (;;) {
#pragma unroll
    for (int i = 0; i < 3; ++i) { const int p = tid + i * NT; if (p < 131 * 8) *(LAS u32x4*)(XR + p * 8) = px[i]; }
#pragma unroll
    for (int i = 0; i < 2; ++i) { const int p = tid + i * NT; *(LAS u32x4*)(GG + p * 8) = pg[i]; }
    const int nitem = item + G; const bool more = nitem < 1024;
    const int ng = nitem & 3, nb = (nitem >> 2) & 7, nchunk = nitem >> 5;
    const bf16* wA = (const bf16*)(a.ws + WS_SMALL + SM_LRUA) + (l * 4 + g) * 64 * 64;
    const bf16* wX = (const bf16*)(a.ws + WS_SMALL + SM_LRUX) + (l * 4 + g) * 64 * 64;
    const float* ba = a.in[I_LBA] + l * 256 + g * 64; const float* bx = a.in[I_LBX] + l * 256 + g * 64; const float* lam = (const float*)(a.ws + WS_SMALL + SM_SPL) + l * 256 + g * 64;
    bf16x8 fa[2][4], fx[2][4];
#pragma unroll
    for (int ks = 0; ks < 2; ++ks)
#pragma unroll
        for (int mt = 0; mt < 4; ++mt) { fa[ks][mt] = *(const bf16x8*)(wA + (mt * 16 + r) * 64 + ks * 32 + 8 * qd); fx[ks][mt] = *(const bf16x8*)(wX + (mt * 16 + r) * 64 + ks * 32 + 8 * qd); }
    f32x4 vba[4], vbx[4], vlam[4];
#pragma unroll
    for (int mt = 0; mt < 4; ++mt) { const int d0 = mt * 16 + 4 * qd; vba[mt] = *(const f32x4*)(ba + d0); vbx[mt] = *(const f32x4*)(bx + d0); vlam[mt] = *(const f32x4*)(lam + d0); }
    if (more) LRUA_LOAD(nb, ng, nchunk * 128);
    WG_BAR();
#pragma unroll
    for (int i = 0; i < 8; ++i) { const int t = (tid >> 5) + 16 * i; float x0 = cb[0], x1 = cb[1];
#pragma unroll
        for (int w = 0; w < 4; ++w) { const unsigned v = *(const LAS unsigned*)(XR + (t + w) * 64 + 2 * cpair); x0 += cw[w][0] * bf2f(v & 0xffffu); x1 += cw[w][1] * bf2f(v >> 16); }
        *(LAS unsigned*)(XC + t * XCS + 2 * cpair) = pk2(x0, x1); }
    WG_BAR();
    { f32x4 ra[4], ri[4];
#pragma unroll
      for (int mt = 0; mt < 4; ++mt) { ra[mt] = (f32x4){0.f, 0.f, 0.f, 0.f}; ri[mt] = (f32x4){0.f, 0.f, 0.f, 0.f}; }
#pragma unroll
      for (int ks = 0; ks < 2; ++ks) { const bf16x8 xf = *(const LAS bf16x8*)(XC + (wave * 16 + r) * XCS + ks * 32 + 8 * qd);
#pragma unroll
          for (int mt = 0; mt < 4; ++mt) { ra[mt] = MFMA16(fa[ks][mt], xf, ra[mt]); ri[mt] = MFMA16(fx[ks][mt], xf, ri[mt]); } }
      const int t = wave * 16 + r;
#pragma unroll
      for (int mt = 0; mt < 4; ++mt) { const int d0 = mt * 16 + 4 * qd;
          const u32x2 xw = *(const LAS u32x2*)(XC + t * XCS + d0);
          const float xc[4] = {bf2f(xw.x & 0xffffu), bf2f(xw.x >> 16), bf2f(xw.y & 0xffffu), bf2f(xw.y >> 16)};
          f32x4 av, bv;
#pragma unroll
          for (int i = 0; i < 4; ++i) { const float rr = sigmoidf_(ra[mt][i] + vba[mt][i]), ii = sigmoidf_(ri[mt][i] + vbx[mt][i]);
              const float sp = vlam[mt][i];
              const float la = -8.0f * rr * sp; const float x2 = 2.0f * la;
              const float aa = __expf(la);
              float om;
              if (x2 > -0.25f) om = -x2 * (1.0f + x2 * (0.5f + x2 * (0.16666667f + x2 * (0.041666668f + x2 * (0.0083333338f + x2 * 0.0013888889f))))); else om = 1.0f - __expf(x2);
              av[i] = aa; bv[i] = __builtin_sqrtf(om) * ii * xc[i]; }
          *(LAS f32x4*)(A_ + t * AS + d0) = av; *(LAS f32x4*)(B_ + t * AS + d0) = bv; }
    }
    WG_BAR();
    { float Pp = 1.f, H = 0.f;
#pragma unroll
      for (int k = 0; k < 16; ++k) { const float aa = A_[(wave * 16 + k) * AS + lane], bb = B_[(wave * 16 + k) * AS + lane]; H = aa * H + bb; Pp *= aa; }
      PH[(wave * 64 + lane) * 2] = Pp; PH[(wave * 64 + lane) * 2 + 1] = H; }
    WG_BAR();
    { float ch = 0.f, cp = 1.f, hin = 0.f, pin = 1.f;
#pragma unroll
      for (int w = 0; w < 8; ++w) { if (w == wave) { hin = ch; pin = cp; } const float pw = PH[(w * 64 + lane) * 2], hw = PH[(w * 64 + lane) * 2 + 1]; ch = pw * ch + hw; cp *= pw; }
      if (wave == 7) { float* sp = SUM + ((size_t)(b * 32 + chunk) * 2) * 256 + g * 64 + lane; sp[0] = cp; sp[256] = ch;
          __builtin_amdgcn_fence(__ATOMIC_RELEASE, "agent"); asm volatile("s_waitcnt vmcnt(0)" ::: "memory");
          if (lane == 0) __hip_atomic_store(FLG + (b * 4 + g) * 32 + chunk, 1u, __ATOMIC_RELAXED, __HIP_MEMORY_SCOPE_AGENT); }
      if (wave == 0 && chunk > 0) { unsigned spins = 0;
          for (;;) { unsigned v = 1u; if (lane < chunk) v = __hip_atomic_load(FLG + (b * 4 + g) * 32 + lane, __ATOMIC_RELAXED, __HIP_MEMORY_SCOPE_AGENT);
              if (__all(v != 0u)) break; __builtin_amdgcn_s_sleep(2); if (++spins > (1u << 22)) break; }
          __builtin_amdgcn_fence(__ATOMIC_ACQUIRE, "agent"); asm volatile("s_waitcnt vmcnt(0)" ::: "memory"); }
      WG_BAR();
      float c = 0.f;
      { const float* sp = SUM + ((size_t)(b * 32) * 2) * 256 + g * 64 + lane;
        float pj[31], hj[31];
#pragma unroll
        for (int j = 0; j < 31; ++j) { pj[j] = 1.f; hj[j] = 0.f; if (j < chunk) { pj[j] = sp[(size_t)j * 512]; hj[j] = sp[(size_t)j * 512 + 256]; } }
#pragma unroll
        for (int j = 0; j < 31; ++j) c = pj[j] * c + hj[j]; }
      float hcur = pin * c + hin;
#pragma unroll
      for (int k = 0; k < 16; ++k) { const int t = wave * 16 + k; const float aa = A_[t * AS + lane], bb = B_[t * AS + lane]; hcur = aa * hcur + bb;
          const float gv = gelu_tanh(bf2f((unsigned)GG[t * 64 + lane]));
          Y[(size_t)(b * SEQ + t0 + t) * D + 768 + g * 64 + lane] = (bf16)f2bf(hcur * gv); }
    }
    WG_BAR();
    if (!more) break;
    if (ng != g) { g = ng; LRUA_CONVW(g); }
    item = nitem; chunk = nchunk; b = nb; t0 = nchunk * 128;
    }
#undef LRUA_LOAD
#undef LRUA_CONVW
}
__device__ __forceinline__ void mixer_part(const Args& a, int part, int l, int bid, int G, LAS unsigned char* lds, int tid, int wave, int lane) {
    asm volatile("" : "+s"(bid));
    constexpr int N_SGU = 256;
    lruA_loop(a, l, bid, G, lds, tid, wave, lane);
    for (int it = bid; it < N_SGU; it += G) sgu_item(a, l, it, lds, tid, wave, lane);
    pool_loop(a, l, bid, G, lds, tid, wave, lane);
    sb_loop(a, bid, G, lds, tid, wave, lane);
}

#define XB_TMO      128
#define XB_XCNT(j)  (256  + 64 * (j))
#define XB_XSUB(j)  (1280 + 64 * (j))
#define XB_XGEN(j)  (2304 + 64 * (j))
#define XB_TOP      3328
#define XB_TOPGEN   3392
#define XCD_BAR_WORDS 3456
#define XB_SPIN_CAP (1u << 22)

__device__ __forceinline__ unsigned xb_ld(unsigned* p)              { return __hip_atomic_load(p, __ATOMIC_RELAXED, __HIP_MEMORY_SCOPE_AGENT); }
__device__ __forceinline__ unsigned xb_add(unsigned* p, unsigned v) { return __hip_atomic_fetch_add(p, v, __ATOMIC_RELAXED, __HIP_MEMORY_SCOPE_AGENT); }
__device__ __forceinline__ unsigned xb_xcc_id() { return (unsigned)__builtin_amdgcn_s_getreg((3 << 11) | 20) & 0xFu; }
#define XB_SPIN(cond, bar) do { unsigned _sp = 0; while (cond) { __builtin_amdgcn_s_sleep(1); \
    if ((++_sp & 255u) == 0u) { if (xb_ld(&(bar)[XB_TMO])) break; if (_sp > XB_SPIN_CAP) { atomicAdd(&(bar)[XB_TMO], 1u); break; } } } } while (0)

struct XcdBarrier {
    unsigned* bar; unsigned x;
    volatile LAS unsigned* st;
};

__device__ __forceinline__ XcdBarrier xcd_barrier_post(unsigned* bar, volatile LAS unsigned* st) {
    XcdBarrier b; b.bar = bar; b.x = xb_xcc_id(); b.st = st;
    if (threadIdx.x == 0) (void)xb_add(&bar[XB_XCNT(b.x)], 1u);
    return b;
}
__device__ __forceinline__ void xcd_barrier_complete(unsigned* bar, unsigned x, unsigned& nloc, unsigned& nx) {
    const unsigned G = gridDim.x * gridDim.y * gridDim.z;
    unsigned sum, cnt, mine, sp = 0u;
    for (;;) {
        sum = 0u; cnt = 0u; mine = 0u;
#pragma unroll
        for (unsigned j = 0; j < 16; ++j) { const unsigned c = xb_ld(&bar[XB_XCNT(j)]); sum += c; cnt += (c > 0u) ? 1u : 0u; mine = (j == x) ? c : mine; }
        if (sum == G) break;
        __builtin_amdgcn_s_sleep(1);
        if ((++sp & 255u) == 0u) { if (xb_ld(&bar[XB_TMO])) break; if (sp > XB_SPIN_CAP) { atomicAdd(&bar[XB_TMO], 1u); break; } }
    }
    nloc = mine > 0u ? mine : 1u; nx = cnt > 0u ? cnt : 1u;
}

__device__ __forceinline__ void xcd_barrier(const XcdBarrier& b) {
    asm volatile("s_waitcnt vmcnt(0)" ::: "memory");
    __syncthreads();
    if (threadIdx.x == 0) {
        unsigned* bar = b.bar;
        __builtin_amdgcn_s_waitcnt(0);
        unsigned nloc = b.st[0], nx = b.st[1];
        if (nloc == 0u) { xcd_barrier_complete(bar, b.x, nloc, nx); b.st[0] = nloc; b.st[1] = nx; }
        const unsigned old = xb_add(&bar[XB_XSUB(b.x)], 1u);
        const unsigned gen = old / nloc;
        if (old + 1u == (gen + 1u) * nloc) {
            __builtin_amdgcn_fence(__ATOMIC_RELEASE, "agent");
            asm volatile("s_waitcnt vmcnt(0)" ::: "memory");
            const unsigned og = xb_add(&bar[XB_TOP], 1u);
            const unsigned tg = og / nx;
            if (og + 1u == (tg + 1u) * nx) xb_add(&bar[XB_TOPGEN], 1u);
            else XB_SPIN(xb_ld(&bar[XB_TOPGEN]) == tg, bar);
            __builtin_amdgcn_fence(__ATOMIC_ACQUIRE, "agent");
            xb_add(&bar[XB_XGEN(b.x)], 1u);
            asm volatile("s_waitcnt vmcnt(0)" ::: "memory");
        } else {
            XB_SPIN(xb_ld(&bar[XB_XGEN(b.x)]) == gen, bar);
            __builtin_amdgcn_fence(__ATOMIC_ACQUIRE, "agent");
            asm volatile("s_waitcnt vmcnt(0)" ::: "memory");
        }
    }
    __syncthreads();
}

__global__ void __launch_bounds__(NT, 2) fwd_kernel(Args a) {
    extern __shared__ __attribute__((aligned(16))) unsigned char lds_raw[];
    LAS unsigned char* lds = (LAS unsigned char*)lds_raw;
    const int tid = threadIdx.x, lane = tid & 63, wave = __builtin_amdgcn_readfirstlane(tid >> 6);
    const int G = gridDim.x, bid = blockIdx.x;
    unsigned char* ws = a.ws;
    const int lo = a.ph_lo, hi = a.ph_hi;
    pg8::ssq_t* ssbase = (pg8::ssq_t*)(ws + WS_SS);
    bf16* XB = (bf16*)(ws + WS_XB); bf16* YB = (bf16*)(ws + WS_Y); bf16* ACT = (bf16*)(ws + WS_ACT); bf16* VT = (bf16*)(ws + WS_VT);
    volatile LAS unsigned* bst = (volatile LAS unsigned*)(lds + RING_BYTES + 64);
    if (tid < 2) bst[tid] = 0u;
    __syncthreads();
    XcdBarrier bar; bar.bar = (unsigned*)(ws + WS_CTL) + CW_BAR; bar.x = 0; bar.st = bst;
#define SEAM() do { if (hi - lo > 1) xcd_barrier(bar); } while (0)
    int ph = 0;
    if (lo <= ph && ph < hi) { for (int rep = 0; rep < REP_PRO; ++rep) { prologue(a, lds, G, bid, wave, lane, tid); __syncthreads(); if (hi - lo > 1) cg::this_grid().sync(); } }
    if (hi - lo > 1) bar = xcd_barrier_post((unsigned*)(ws + WS_CTL) + CW_BAR, bst);
    ++ph;
#pragma unroll 1
    for (int st = 0; st < 7 * DEPTH; ++st) {
        const int l = st / 7, k = st - 7 * l;
        unsigned char* wl = ws + WS_W + l * W_LAYER;
        if (k == 0 || k == 5) {
            pg8::Gemm g{XB, (const bf16*)(wl + (k == 0 ? WO_F1IN : WO_F2IN)), M, 2 * DFF, D}; pg8::StaticOrder S; S.init(M, 2 * DFF, G, bid);
            pg8::EpiSwiGLU E{ACT, ssbase + (3 * l + (k == 0 ? 0 : 2)) * M, DFF, {}}; pg8::gemm_phase<pg8::EpiSwiGLU, pg8::StaticOrder, true, true>(lds, g, S, E);
        } else if (k == 1 || k == 4 || k == 6) {
            const bf16* Ap = (k == 4) ? YB : ACT; const int Kk = (k == 4) ? D : DFF;
            const bf16* Bp = (const bf16*)(wl + (k == 1 ? WO_F1OUT : (k == 4 ? WO_MOUT : WO_F2OUT)));
            pg8::Gemm g{Ap, Bp, M, D, Kk}; pg8::StaticOrder S; S.init(M, D, G, bid);
            pg8::EpiResidual E{nullptr, XB, ssbase + (3 * l + (k == 1 ? 1 : (k == 4 ? 2 : 3))) * M, (k == 4) ? 1.0f : 0.5f};
            pg8::gemm_phase<pg8::EpiResidual, pg8::StaticOrder, true, true>(lds, g, S, E);
        } else if (k == 2) {
            pg8::Gemm g{XB, (const bf16*)(wl + WO_MIN), M, DIN, D}; pg8::StaticOrder S; S.init(M, DIN, G, bid);
            pg8::EpiMixIn E{ACT, ssbase + (3 * l + 1) * M, VT, {}}; pg8::gemm_phase<pg8::EpiMixIn, pg8::StaticOrder, true, true>(lds, g, S, E);
        } else {
            mixer_part(a, 0, l, bid, G, lds, tid, wave, lane);
        }
        SEAM();
    }
    ph += 7 * DEPTH;
    if (lo <= ph && ph < hi) final_norm(a, G, bid, wave, lane);
}
constexpr int N_PHASES = 2 + 7 * DEPTH;

#ifndef MK_MULTI
#define MK_MULTI 0
#endif
extern "C" void kernel_launch(void* const* d_in, const int* in_sizes, int n_in, void* d_out, int out_size, void* d_ws, size_t ws_size, hipStream_t stream) {
    static int grid = 0;
    if (grid == 0) {
        if (n_in != 22 || in_sizes[0] != M * D || out_size != M * D || ws_size < WS_END) { fprintf(stderr, "kernel_launch: unexpected shapes/workspace (n_in %d, ws %zu)\n", n_in, ws_size); grid = -1; return; }
        int dev = 0, cus = 0, per_cu = 0;
        hipGetDevice(&dev); hipDeviceGetAttribute(&cus, hipDeviceAttributeMultiprocessorCount, dev);
        if (hipFuncSetAttribute((const void*)fwd_kernel, hipFuncAttributeMaxDynamicSharedMemorySize, LDS_BYTES) != hipSuccess) { fprintf(stderr, "kernel_launch: hipFuncSetAttribute failed\n"); grid = -1; return; }
        hipOccupancyMaxActiveBlocksPerMultiprocessor(&per_cu, (const void*)fwd_kernel, NT, LDS_BYTES);
        (void)hipGetLastError();
        if (per_cu < 1) per_cu = 1;
        grid = cus * 1;
    }
    if (grid < 0) return;
    Args a{};
    for (int i = 0; i < 22; ++i) a.in[i] = (const float*)d_in[i];
    a.out = (float*)d_out; a.ws = (unsigned char*)d_ws;
#if MK_MULTI
    for (int p = 0; p < N_PHASES; ++p) { a.ph_lo = p; a.ph_hi = p + 1; hipLaunchKernelGGL(fwd_kernel, dim3(grid), dim3(NT), LDS_BYTES, stream, a); }
#else
    a.ph_lo = 0; a.ph_hi = N_PHASES;
    void* args[] = {&a};
    hipError_t e = hipLaunchCooperativeKernel((const void*)fwd_kernel, dim3(grid), dim3(NT), args, LDS_BYTES, stream);
    if (e != hipSuccess) fprintf(stderr, "cooperative launch failed: %s (grid %d)\n", hipGetErrorString(e), grid);
#endif
}
```
